# Optimizing an MI355X kernel written in HIP

```python
import jax, jax.numpy as jnp
from jax import lax
import numpy as np

D_MODEL = 1024
BATCH = 1
SEQ = 16384
DEPTH = 1

GRID_W = 64
D_CONV = 512
CONV_K = 31
NA_HEADS = 8
NA_HEAD_DIM = 64
D_NA = NA_HEADS * NA_HEAD_DIM
D_IN = 2 * D_CONV + 3 * D_NA
D_MIX = D_CONV + D_NA
WIN_H = 8
WIN_W = 16
QB = WIN_W
KBW = 2 * WIN_W
N_COL_BLOCKS = GRID_W // QB
N_EXPERTS = 32
TOP_K = 4
D_FF = D_MODEL
SWIGLU_LIMIT = 7.0
SWIGLU_ALPHA = 1.702
MOE_BLOCK = 128
EPS = 1e-5

kernel_name = "hybrid_conformer_conv_natten2d_moe_encoder"


def rmsnorm(x, g):
    xf = x.astype(jnp.float32)
    y = xf * lax.rsqrt(jnp.mean(xf * xf, axis=-1, keepdims=True) + EPS) * g.astype(jnp.float32)
    return y.astype(x.dtype)


def conformer_conv(a, g, conv_w, conv_b, ln_g, ln_b):
    u = a * jax.nn.sigmoid(g)
    u = lax.conv_general_dilated(
        u, conv_w[:, None, :].astype(u.dtype), window_strides=(1,),
        padding=[(CONV_K // 2, CONV_K // 2)],
        dimension_numbers=("NWC", "WIO", "NWC"),
        feature_group_count=D_CONV) + conv_b
    uf = u.astype(jnp.float32)
    mu = jnp.mean(uf, axis=-1, keepdims=True)
    var = jnp.mean(jnp.square(uf - mu), axis=-1, keepdims=True)
    un = (uf - mu) * lax.rsqrt(var + EPS) * ln_g.astype(jnp.float32) + ln_b.astype(jnp.float32)
    return jax.nn.silu(un).astype(a.dtype)


def neighbourhood_attention(q, k, v, rpb):
    B, S, H, Dh = q.shape
    rows = S // GRID_W
    kh = min(WIN_H, rows)
    scale = Dh ** -0.5
    qg = q.reshape(B, rows, N_COL_BLOCKS, QB, H, Dh)
    kg = k.reshape(B, rows, GRID_W, H, Dh)
    vg = v.reshape(B, rows, GRID_W, H, Dh)

    col = jnp.arange(GRID_W, dtype=jnp.int32).reshape(N_COL_BLOCKS, QB)
    c0 = jnp.clip(col - WIN_W // 2, 0, GRID_W - WIN_W)
    blk_start = jnp.clip(jnp.arange(N_COL_BLOCKS, dtype=jnp.int32) * QB - WIN_W // 2, 0, GRID_W - KBW)
    key_col = blk_start[:, None] + jnp.arange(KBW, dtype=jnp.int32)[None, :]
    col_valid = (key_col[:, None, :] >= c0[:, :, None]) & (key_col[:, None, :] < c0[:, :, None] + WIN_W)
    dcol_idx = jnp.clip(key_col[:, None, :] - col[:, :, None], -(WIN_W - 1), WIN_W - 1) + (WIN_W - 1)
    valid = col_valid[None, :, None, :, None, :]

    def row_fn(args):
        i, q_row = args
        r0 = jnp.clip(i - kh // 2, 0, rows - kh)
        k_slab = lax.dynamic_slice_in_dim(kg, r0, kh, axis=1)
        v_slab = lax.dynamic_slice_in_dim(vg, r0, kh, axis=1)
        k_blk = k_slab[:, :, key_col]
        v_blk = v_slab[:, :, key_col]
        s = jnp.einsum("bnqhd,brnkhd->bnhqrk", q_row, k_blk,
                       preferred_element_type=jnp.float32) * scale
        drow_idx = r0 + jnp.arange(kh, dtype=jnp.int32) - i + (WIN_H - 1)
        bias = rpb[:, drow_idx[None, None, :, None], dcol_idx[:, :, None, :]]
        s = s + jnp.moveaxis(bias, 0, 1)[None].astype(jnp.float32)
        s = jnp.where(valid, s, jnp.float32(-1e30))
        p = jax.nn.softmax(s.reshape(B, N_COL_BLOCKS, H, QB, kh * KBW), axis=-1)
        p = p.reshape(B, N_COL_BLOCKS, H, QB, kh, KBW).astype(v.dtype)
        return jnp.einsum("bnhqrk,brnkhd->bnqhd", p, v_blk)

    out = lax.map(row_fn, (jnp.arange(rows, dtype=jnp.int32), jnp.moveaxis(qg, 1, 0)))
    return jnp.moveaxis(out, 0, 1).reshape(B, S, H * Dh)


def mixer(xn, w_in, b_in, conv_w, conv_b, ln_g, ln_b, rpb, w_out, b_out):
    B, S, _ = xn.shape
    proj = jnp.einsum("bsd,de->bse", xn, w_in) + b_in
    glu_a, glu_g, q, k, v = jnp.split(
        proj, [D_CONV, 2 * D_CONV, 2 * D_CONV + D_NA, 2 * D_CONV + 2 * D_NA], axis=-1)
    conv_out = conformer_conv(glu_a, glu_g, conv_w, conv_b, ln_g, ln_b)
    na_out = neighbourhood_attention(q.reshape(B, S, NA_HEADS, NA_HEAD_DIM),
                                     k.reshape(B, S, NA_HEADS, NA_HEAD_DIM),
                                     v.reshape(B, S, NA_HEADS, NA_HEAD_DIM), rpb)
    mixed = jnp.concatenate([conv_out, na_out], axis=-1)
    return jnp.einsum("bse,ed->bsd", mixed, w_out) + b_out


def moe(xn, w_router, b_router, w_gate, b_gate, w_up, b_up, w_down, b_down):
    B, S, D = xn.shape
    T = B * S
    xt = xn.reshape(T, D)
    logits = (xt @ w_router + b_router).astype(jnp.float32)
    top_vals, top_idx = lax.top_k(logits, TOP_K)
    gates = jax.nn.softmax(top_vals, axis=-1)
    tk = T * TOP_K
    exp_flat = top_idx.reshape(tk)
    tok_flat = jnp.arange(tk, dtype=jnp.int32) // TOP_K
    gate_flat = gates.reshape(tk)
    order = jnp.argsort(exp_flat)
    s_exp, s_tok, s_gate = exp_flat[order], tok_flat[order], gate_flat[order]
    sizes = jnp.bincount(exp_flat, length=N_EXPERTS).astype(jnp.int32)
    offsets = jnp.cumsum(sizes) - sizes
    padded = (sizes + MOE_BLOCK - 1) // MOE_BLOCK * MOE_BLOCK
    pad_ends = jnp.cumsum(padded)
    pad_offsets = pad_ends - padded
    dest = pad_offsets[s_exp] + jnp.arange(tk, dtype=jnp.int32) - offsets[s_exp]
    cap = tk + N_EXPERTS * MOE_BLOCK
    n_blocks = cap // MOE_BLOCK
    tok_pad = jnp.zeros((cap,), jnp.int32).at[dest].set(s_tok)
    gate_pad = jnp.zeros((cap,), jnp.float32).at[dest].set(s_gate)
    blk_exp = jnp.minimum(
        jnp.searchsorted(pad_ends, jnp.arange(n_blocks, dtype=jnp.int32) * MOE_BLOCK, side="right"),
        N_EXPERTS - 1).astype(jnp.int32)
    x_blocks = xt[tok_pad].reshape(n_blocks, MOE_BLOCK, D)

    def expert_block(args):
        xb, e = args
        gt = jnp.minimum(xb @ w_gate[e] + b_gate[e], SWIGLU_LIMIT)
        up = jnp.clip(xb @ w_up[e] + b_up[e], -SWIGLU_LIMIT, SWIGLU_LIMIT)
        hdn = (up + 1.0) * (gt * jax.nn.sigmoid(SWIGLU_ALPHA * gt))
        return hdn @ w_down[e] + b_down[e]

    y = lax.map(expert_block, (x_blocks, blk_exp)).reshape(cap, D)
    y = y * gate_pad[:, None].astype(y.dtype)
    out = jax.ops.segment_sum(y, tok_pad, num_segments=T)
    return out.reshape(B, S, D)


def setup_inputs(seed: int = 0) -> dict:
    key = jax.random.key(seed)
    ks = jax.random.split(key, 22)

    def nrm(k, shape, scale):
        return jax.random.normal(k, shape, jnp.float32) * scale

    return {
        "x": nrm(ks[0], (BATCH, SEQ, D_MODEL), 1.0),
        "g_mix": 1.0 + nrm(ks[1], (DEPTH, D_MODEL), 0.02),
        "w_in": nrm(ks[2], (DEPTH, D_MODEL, D_IN), D_MODEL ** -0.5),
        "b_in": nrm(ks[3], (DEPTH, D_IN), 0.01),
        "conv_w": nrm(ks[4], (DEPTH, CONV_K, D_CONV), CONV_K ** -0.5),
        "conv_b": nrm(ks[5], (DEPTH, D_CONV), 0.01),
        "ln_g": 1.0 + nrm(ks[6], (DEPTH, D_CONV), 0.02),
        "ln_b": nrm(ks[7], (DEPTH, D_CONV), 0.01),
        "rpb": nrm(ks[8], (DEPTH, NA_HEADS, 2 * WIN_H - 1, 2 * WIN_W - 1), 0.02),
        "w_out": nrm(ks[9], (DEPTH, D_MIX, D_MODEL), D_MIX ** -0.5),
        "b_out": nrm(ks[10], (DEPTH, D_MODEL), 0.01),
        "g_ffn": 1.0 + nrm(ks[11], (DEPTH, D_MODEL), 0.02),
        "w_router": nrm(ks[12], (DEPTH, D_MODEL, N_EXPERTS), D_MODEL ** -0.5),
        "b_router": nrm(ks[13], (DEPTH, N_EXPERTS), 0.01),
        "w_gate": nrm(ks[14], (DEPTH, N_EXPERTS, D_MODEL, D_FF), D_MODEL ** -0.5),
        "b_gate": nrm(ks[15], (DEPTH, N_EXPERTS, D_FF), 0.01),
        "w_up": nrm(ks[16], (DEPTH, N_EXPERTS, D_MODEL, D_FF), D_MODEL ** -0.5),
        "b_up": nrm(ks[17], (DEPTH, N_EXPERTS, D_FF), 0.01),
        "w_down": nrm(ks[18], (DEPTH, N_EXPERTS, D_FF, D_MODEL), D_FF ** -0.5),
        "b_down": nrm(ks[19], (DEPTH, N_EXPERTS, D_MODEL), 0.01),
        "g_final": 1.0 + nrm(ks[20], (D_MODEL,), 0.02),
    }


def reference(x, g_mix, w_in, b_in, conv_w, conv_b, ln_g, ln_b, rpb, w_out, b_out,
              g_ffn, w_router, b_router, w_gate, b_gate, w_up, b_up, w_down, b_down, g_final):
    h = x
    for l in range(DEPTH):
        xn = rmsnorm(h, g_mix[l])
        h = h + mixer(xn, w_in[l], b_in[l], conv_w[l], conv_b[l], ln_g[l], ln_b[l],
                      rpb[l], w_out[l], b_out[l])
        xn = rmsnorm(h, g_ffn[l])
        h = h + moe(xn, w_router[l], b_router[l], w_gate[l], b_gate[l], w_up[l], b_up[l],
                    w_down[l], b_down[l])
    return rmsnorm(h, g_final)
```

```cpp
#include <hip/hip_runtime.h>
#include <cstdio>
#include <cstdint>

#ifndef MK_N_LAUNCHES
#define MK_N_LAUNCHES 1
#endif

#define GAS __attribute__((address_space(1)))
#define LAS __attribute__((address_space(3)))
typedef unsigned short bf16;
typedef short bf16x8 __attribute__((ext_vector_type(8)));
typedef float f32x4 __attribute__((ext_vector_type(4)));
typedef float f32x2 __attribute__((ext_vector_type(2)));
typedef unsigned u32x4 __attribute__((ext_vector_type(4)));
typedef unsigned u32x2 __attribute__((ext_vector_type(2)));

constexpr int T = 16384, D = 1024, GRIDW = 64, NROWS = 256;
constexpr int DC = 512, CONVK = 31, NHEAD = 8, HDIM = 64, DIN = 2560;
constexpr int NE = 32, DFF = 1024, TK = T * 4;
constexpr float EPS = 1e-5f;
constexpr float LOG2E = 1.4426950408889634f;

constexpr size_t MiB = 1u << 20;
constexpr size_t WS_CTL = 0, CTL_ZERO_BYTES = 65536;
constexpr size_t WS_WIN = 1 * MiB;
constexpr size_t WS_WOUT = 6 * MiB;
constexpr size_t WS_WGU = 8 * MiB;
constexpr size_t WS_WD = 136 * MiB;
constexpr size_t WS_HB = 200 * MiB;
constexpr size_t WS_RS1 = 232 * MiB;
constexpr size_t WS_SSQ = WS_RS1 + 65536;
constexpr size_t WS_RS2 = WS_SSQ + 1 * MiB;
constexpr size_t WS_ERANK = WS_RS2 + 65536;
constexpr size_t WS_LIST = 234 * MiB;
constexpr size_t WS_GLIST = 236 * MiB;
constexpr size_t WS_OVL = 240 * MiB;
constexpr size_t WS_XB = WS_OVL;
constexpr size_t WS_U = WS_OVL + 32 * MiB;
constexpr size_t WS_Q = WS_OVL + 48 * MiB;
constexpr size_t WS_K = WS_OVL + 64 * MiB;
constexpr size_t WS_VT = WS_OVL + 80 * MiB;
constexpr size_t WS_MIX = WS_OVL + 96 * MiB;
constexpr size_t WS_HD = WS_OVL;
constexpr size_t WS_Y = 370 * MiB;
constexpr size_t WS_END = 498 * MiB;
static_assert(WS_HD + (size_t)(TK + 256) * DFF * 2 <= WS_Y && WS_MIX + (size_t)T * D * 2 <= WS_Y && WS_ERANK + (size_t)TK * 4 <= WS_LIST, "ws map");

constexpr int CW_TMO = 0, CW_BAR = 4096, CW_GCOUNT = 8192;

constexpr int RING_BYTES = 131072;
constexpr int AUX_OFF = RING_BYTES;
constexpr int MISC_OFF = AUX_OFF;
constexpr int AUX_TAB = AUX_OFF + 256;
constexpr int LDS_BYTES = 155648;
constexpr int MAXU = 9;
constexpr int MAXTILES = 288;
constexpr int AT_TOK = AUX_TAB;
constexpr int AT_ROWF = AT_TOK + MAXU * 1024;
constexpr int AT_TILE = AT_ROWF + MAXU * 1024;
constexpr int AT_OFFS = AT_TILE + MAXTILES * 4;
constexpr int AT_END = AT_OFFS + 80 * 4;
static_assert(AT_END <= LDS_BYTES, "LDS aux map");

#define RLX_AGENT __ATOMIC_RELAXED, __HIP_MEMORY_SCOPE_AGENT
#define LDS_WAIT() asm volatile("s_waitcnt lgkmcnt(0)" ::: "memory")
#define VM_WAIT() asm volatile("s_waitcnt vmcnt(0)" ::: "memory")

__device__ __forceinline__ unsigned cvt_pk_bf16(float lo, float hi) { unsigned r; asm volatile("v_cvt_pk_bf16_f32 %0, %1, %2" : "=v"(r) : "v"(lo), "v"(hi)); return r; }
__device__ __forceinline__ float bf_lo(unsigned w) { return __uint_as_float(w << 16); }
__device__ __forceinline__ float bf_hi(unsigned w) { return __uint_as_float(w & 0xffff0000u); }
__device__ __forceinline__ float fast_exp2(float x) { return __builtin_amdgcn_exp2f(x); }
__device__ __forceinline__ float fast_rcp(float x) { return __builtin_amdgcn_rcpf(x); }
__device__ __forceinline__ float sigmoidf_(float x) { return fast_rcp(1.0f + fast_exp2(-LOG2E * x)); }

namespace pg8 {
constexpr int BM = 256, BK = 64, HALF = 128, HTB = HALF * BK * 2, STAGE_BYTES = 8 * HTB, NXCD = 8, WGM = 8;
__host__ __device__ __forceinline__ int lds_byte(int r, int c) { const int st = (r >> 4) * 2 + (c >> 5), rr = r & 15, cc = c & 31, ob = rr * 64 + cc * 2; return st * 1024 + (ob ^ (((ob >> 9) & 1) << 5)); }
__host__ __device__ __forceinline__ void stage_rc(int b, int& R, int& C) { const int st = b / 1024, sb = b % 1024, swz = sb ^ (((sb >> 9) & 1) << 5); R = (st >> 1) * 16 + swz / 64; C = (st & 1) * 32 + (swz % 64) / 2; }
__host__ __device__ __forceinline__ int perm32(int rho) { const int n = rho >> 4, i = rho & 15; return 8 * (i >> 2) + 4 * n + (i & 3); }

struct Unit { const char* A; const char* B; int pm, pn, slot; };

struct StaticOrder {
    static constexpr bool GATHER = false;
    const char* A; const char* Bt; int K; int nM, nN, nwg, G, c;
    __device__ void init(const void* A_, const void* Bt_, int M, int N, int K_, int G_, int c_) { A = (const char*)A_; Bt = (const char*)Bt_; K = K_; nM = M / BM; nN = N / BM; nwg = nM * nN; G = G_; c = c_; }
    __device__ __forceinline__ bool next(int i, Unit& u) const {
        const long L = (long)i * G + c; if (L >= nwg) return false;
        int wgid = (int)L; { const int q = nwg / NXCD, r = nwg % NXCD, xcd = wgid % NXCD, off = wgid / NXCD; wgid = (xcd < r ? xcd * (q + 1) : r * (q + 1) + (xcd - r) * q) + off; }
        const int nig = WGM * nN, gid = wgid / nig, fm = gid * WGM, gsz = (nM - fm) < WGM ? (nM - fm) : WGM;
        u.pm = fm + ((wgid % nig) % gsz); u.pn = (wgid % nig) / gsz;
        u.A = A + (size_t)u.pm * BM * K * 2; u.B = Bt + (size_t)u.pn * BM * K * 2; u.slot = 0; return true;
    }
    __device__ __forceinline__ void voff(const Unit&, unsigned (&v)[2][2]) const {
#pragma unroll
        for (int i = 0; i < 2; ++i) { int R, C; stage_rc((int)threadIdx.x * 16 + i * 8192, R, C);
#pragma unroll
            for (int h = 0; h < 2; ++h) v[h][i] = (unsigned)((R + HALF * h) * K + C) * 2u; }
    }
};

template <bool GATHER_> struct GroupedOrder {
    static constexpr bool GATHER = GATHER_;
    const char* A; const char* Bt; int K; int ntn, Nexp  , G, c, ntiles;
    const LAS int* tile; const LAS int* offs; const LAS unsigned* tokoff;
    __device__ __forceinline__ bool next(int i, Unit& u) const {
        const int L = i * G + c; if (L >= ntiles * ntn) return false;
        const int mt = L / ntn; u.pn = L - mt * ntn; const int te = tile[mt], e = te >> 16, j = te & 0xffff;
        u.pm = mt; u.slot = i;
        u.A = GATHER ? A : A + (size_t)(offs[e] + 256 * j) * K * 2;
        u.B = Bt + ((size_t)e * Nexp + (size_t)u.pn * BM) * K * 2; return true;
    }
    __device__ __forceinline__ void voff(const Unit& u, unsigned (&v)[2][2]) const {
#pragma unroll
        for (int i = 0; i < 2; ++i) { int R, C; stage_rc((int)threadIdx.x * 16 + i * 8192, R, C);
#pragma unroll
            for (int h = 0; h < 2; ++h) v[h][i] = GATHER ? tokoff[u.slot * 256 + R + HALF * h] + (unsigned)C * 2u : (unsigned)((R + HALF * h) * K + C) * 2u; }
    }
    __device__ __forceinline__ void meta(const Unit& u, int& e, int& row0, int& nvalid) const { const int te = tile[u.pm]; e = te >> 16; const int j = te & 0xffff; row0 = offs[e] + 256 * j; const int rem = offs[33 + e] - 256 * j; nvalid = rem < 256 ? rem : 256; }
};

template <class Epi, class Sched, bool ALIGN_EPI = true>
__device__ __forceinline__ void gemm_phase(LAS unsigned char* lds, const int K, const Sched& S, const Epi& E) {
    const int tid = threadIdx.x, wid = __builtin_amdgcn_readfirstlane(tid >> 6), lane = tid & 63, wr = wid >> 2, wc = wid & 3, fr = lane & 15, fq = lane >> 4;
    const int nt = K / BK;
    unsigned voffB[2];
#pragma unroll
    for (int i = 0; i < 2; ++i) { int R, C; stage_rc(tid * 16 + i * 8192, R, C); const int Rb = (R & ~31) + perm32(R & 31); voffB[i] = (unsigned)(Rb * K + C) * 2u; }
    const size_t kstep = (size_t)(BK * 2);
    const size_t hstep = (size_t)HALF * K * 2;
    const unsigned ldsw = (unsigned)wid * 1024u;
    const int aoff = lds_byte(wr * 64 + fr, fq * 8), boff = lds_byte(wc * 32 + fr, fq * 8);
#define PG8_SA(b, h) (((b) * 2 + (h)) * HTB)
#define PG8_SB(b, h) ((4 + (b) * 2 + (h)) * HTB)
#define PG8_STAGE2(bufoff, gbase, v0, v1) do { \
        __builtin_amdgcn_global_load_lds((const unsigned*)((const char*)(gbase) + (v0)), (LAS unsigned*)(lds + (bufoff) + ldsw), 16, 0, 0); \
        __builtin_amdgcn_global_load_lds((const unsigned*)((const char*)(gbase) + (v1)), (LAS unsigned*)(lds + (bufoff) + ldsw + 8192), 16, 0, 0); } while (0)
#define PG8_STAGEB(bufoff, gbase) PG8_STAGE2(bufoff, gbase, voffB[0], voffB[1])
#define PG8_LDA(dst, b, h) do { _Pragma("unroll") for (int m = 0; m < 4; ++m) _Pragma("unroll") for (int k = 0; k < 2; ++k) dst[m][k] = *(const LAS bf16x8*)(lds + PG8_SA(b, h) + aoff + m * 2048 + k * 1024); } while (0)
#define PG8_LDB(dst, b, h) do { _Pragma("unroll") for (int n = 0; n < 2; ++n) _Pragma("unroll") for (int k = 0; k < 2; ++k) dst[n][k] = *(const LAS bf16x8*)(lds + PG8_SB(b, h) + boff + n * 2048 + k * 1024); } while (0)
#define PG8_MMA(ai, bj, At, Bt) do { __builtin_amdgcn_s_setprio(1); _Pragma("unroll") for (int m = 0; m < 4; ++m) _Pragma("unroll") for (int n = 0; n < 2; ++n) _Pragma("unroll") for (int k = 0; k < 2; ++k) \
        acc[ai][bj][m][n] = __builtin_amdgcn_mfma_f32_16x16x32_bf16(Bt[n][k], At[m][k], acc[ai][bj][m][n], 0, 0, 0); __builtin_amdgcn_s_setprio(0); } while (0)
#define PG8_WAIT_V(n) asm volatile("s_waitcnt vmcnt(" #n ")" ::: "memory")
#define PG8_WAIT_L(n) asm volatile("s_waitcnt lgkmcnt(" #n ")" ::: "memory")
#define PG8_BAR __builtin_amdgcn_s_barrier()
#define PG8_SCHED __builtin_amdgcn_sched_barrier(0)
    Unit cur, nxt; int ui = 0;
    if (!S.next(0, cur)) return;
    unsigned vAc[2][2];
    S.voff(cur, vAc);
    f32x4 acc[2][2][4][2];
#pragma unroll
    for (int a = 0; a < 2; ++a)
#pragma unroll
        for (int b = 0; b < 2; ++b)
#pragma unroll
            for (int m = 0; m < 4; ++m)
#pragma unroll
                for (int n = 0; n < 2; ++n) acc[a][b][m][n] = (f32x4){0.f, 0.f, 0.f, 0.f};
    bf16x8 At[4][2], B0[2][2], B1[2][2];
    const char* cA = cur.A; const char* cB = cur.B;
    PG8_STAGEB(PG8_SB(0, 0), cB); PG8_STAGEB(PG8_SB(0, 1), cB + hstep); PG8_STAGE2(PG8_SA(0, 0), cA, vAc[0][0], vAc[0][1]); PG8_STAGE2(PG8_SA(0, 1), cA, vAc[1][0], vAc[1][1]);
    if (wr == 1) PG8_BAR;
    PG8_WAIT_V(2); PG8_BAR;
    PG8_STAGEB(PG8_SB(1, 0), cB + kstep); PG8_STAGE2(PG8_SA(1, 0), cA + kstep, vAc[0][0], vAc[0][1]); PG8_STAGEB(PG8_SB(1, 1), cB + hstep + kstep);
    PG8_WAIT_V(6); PG8_BAR;
    for (;;) {
        const bool has_next = S.next(ui + 1, nxt);
        const char* nA = has_next ? nxt.A : cA; const char* nB = has_next ? nxt.B : cB;
        for (int t = 0; t < nt; t += 2) {
            const bool last = (t == nt - 2);
            const char* a1 = cA + (size_t)(t + 1) * kstep;
            const char* a2 = last ? nA : cA + (size_t)(t + 2) * kstep; const char* b2 = last ? nB : cB + (size_t)(t + 2) * kstep;
            const char* a3 = a2 + kstep; const char* b3 = b2 + kstep;
            unsigned w00 = vAc[0][0], w01 = vAc[0][1], w10 = vAc[1][0], w11 = vAc[1][1];
            if constexpr (Sched::GATHER) { if (last && has_next) { unsigned vn[2][2]; S.voff(nxt, vn); w00 = vn[0][0]; w01 = vn[0][1]; w10 = vn[1][0]; w11 = vn[1][1]; } }
            PG8_LDB(B0, 0, 0); PG8_LDB(B1, 0, 1); PG8_SCHED; PG8_LDA(At, 0, 0); PG8_STAGE2(PG8_SA(1, 1), a1, vAc[1][0], vAc[1][1]);
            PG8_WAIT_V(8); PG8_WAIT_L(0); PG8_BAR; PG8_MMA(0, 0, At, B0); PG8_MMA(0, 1, At, B1); PG8_BAR; PG8_SCHED;
            PG8_LDA(At, 0, 1); PG8_STAGEB(PG8_SB(0, 0), b2); PG8_STAGEB(PG8_SB(0, 1), b2 + hstep); PG8_STAGE2(PG8_SA(0, 0), a2, w00, w01);
            PG8_WAIT_V(8); PG8_WAIT_L(0); PG8_BAR; PG8_MMA(1, 0, At, B0); PG8_MMA(1, 1, At, B1); PG8_BAR; PG8_SCHED;
            PG8_LDB(B0, 1, 0); PG8_LDB(B1, 1, 1); PG8_SCHED; PG8_LDA(At, 1, 0); PG8_STAGE2(PG8_SA(0, 1), a2, w10, w11);
            PG8_WAIT_V(8); PG8_WAIT_L(0); PG8_BAR; PG8_MMA(0, 0, At, B0); PG8_MMA(0, 1, At, B1); PG8_BAR; PG8_SCHED;
            PG8_LDA(At, 1, 1); PG8_STAGEB(PG8_SB(1, 0), b3); PG8_STAGEB(PG8_SB(1, 1), b3 + hstep); PG8_STAGE2(PG8_SA(1, 0), a3, w00, w01);
            PG8_WAIT_V(8); PG8_WAIT_L(0); PG8_BAR; PG8_MMA(1, 0, At, B0); PG8_MMA(1, 1, At, B1); PG8_BAR; PG8_SCHED;
        }
        if constexpr (ALIGN_EPI) { if (wr == 0) PG8_BAR; }
        E(acc, cur, wr, wc, fr, fq);
        if (!has_next) break;
#pragma unroll
        for (int a = 0; a < 2; ++a)
#pragma unroll
            for (int b = 0; b < 2; ++b)
#pragma unroll
                for (int m = 0; m < 4; ++m)
#pragma unroll
                    for (int n = 0; n < 2; ++n) acc[a][b][m][n] = (f32x4){0.f, 0.f, 0.f, 0.f};
        cur = nxt; cA = nA; cB = nB; ++ui;
        if constexpr (Sched::GATHER) S.voff(cur, vAc);
        if constexpr (ALIGN_EPI) { if (wr == 1) PG8_BAR; }
    }
    PG8_WAIT_V(0);
    if constexpr (!ALIGN_EPI) { if (wr == 0) PG8_BAR; }
    PG8_BAR;
#undef PG8_SA
#undef PG8_SB
#undef PG8_STAGE2
#undef PG8_STAGEB
#undef PG8_LDA
#undef PG8_LDB
#undef PG8_MMA
#undef PG8_WAIT_V
#undef PG8_WAIT_L
#undef PG8_BAR
#undef PG8_SCHED
}
}

#define XB_TMO      128
#define XB_XCNT(j)  (256  + 64 * (j))
#define XB_XSUB(j)  (1280 + 64 * (j))
#define XB_XGEN(j)  (2304 + 64 * (j))
#define XB_TOP      3328
#define XB_TOPGEN   3392
#define XCD_BAR_WORDS 3456
#define XB_SPIN_CAP (1u << 18)

__device__ __forceinline__ unsigned xb_ld(unsigned* p)              { return __hip_atomic_load(p, __ATOMIC_RELAXED, __HIP_MEMORY_SCOPE_AGENT); }
__device__ __forceinline__ unsigned xb_add(unsigned* p, unsigned v) { return __hip_atomic_fetch_add(p, v, __ATOMIC_RELAXED, __HIP_MEMORY_SCOPE_AGENT); }
__device__ __forceinline__ unsigned xb_xcc_id() { return (unsigned)__builtin_amdgcn_s_getreg((3 << 11) | 20) & 0xFu; }
#define XB_SPIN(cond, bar) do { unsigned _sp = 0; while (cond) { __builtin_amdgcn_s_sleep(1); \
    if ((++_sp & 255u) == 0u) { if (xb_ld(&(bar)[XB_TMO])) break; if (_sp > XB_SPIN_CAP) { atomicAdd(&(bar)[XB_TMO], 1u); break; } } } } while (0)

struct XcdBarrier { unsigned* bar; unsigned x; volatile LAS unsigned* st; };

__device__ __forceinline__ XcdBarrier xcd_barrier_post(unsigned* bar, volatile LAS unsigned* st) {
    XcdBarrier b; b.bar = bar; b.x = xb_xcc_id(); b.st = st;
    if (threadIdx.x == 0) (void)xb_add(&bar[XB_XCNT(b.x)], 1u);
    return b;
}
__device__ __forceinline__ void xcd_barrier_complete(unsigned* bar, unsigned x, unsigned& nloc, unsigned& nx) {
    const unsigned G = gridDim.x * gridDim.y * gridDim.z;
    unsigned sum, cnt, mine, sp = 0u;
    for (;;) {
        sum = 0u; cnt = 0u; mine = 0u;
#pragma unroll
        for (unsigned j = 0; j < 16; ++j) { const unsigned c = xb_ld(&bar[XB_XCNT(j)]); sum += c; cnt += (c > 0u) ? 1u : 0u; mine = (j == x) ? c : mine; }
        if (sum == G) break;
        __builtin_amdgcn_s_sleep(1);
        if ((++sp & 255u) == 0u) { if (xb_ld(&bar[XB_TMO])) break; if (sp > XB_SPIN_CAP) { atomicAdd(&bar[XB_TMO], 1u); break; } }
    }
    nloc = mine > 0u ? mine : 1u; nx = cnt > 0u ? cnt : 1u;
}
__device__ __forceinline__ void xcd_barrier(const XcdBarrier& b) {
    asm volatile("s_waitcnt vmcnt(0)" ::: "memory");
    __syncthreads();
    if (threadIdx.x == 0) {
        unsigned* bar = b.bar;
        __builtin_amdgcn_s_waitcnt(0);
        unsigned nloc = b.st[0], nx = b.st[1];
        if (nloc == 0u) { xcd_barrier_complete(bar, b.x, nloc, nx); b.st[0] = nloc; b.st[1] = nx; }
        const unsigned old = xb_add(&bar[XB_XSUB(b.x)], 1u);
        const unsigned gen = old / nloc;
        if (old + 1u == (gen + 1u) * nloc) {
            __builtin_amdgcn_fence(__ATOMIC_RELEASE, "agent");
            asm volatile("s_waitcnt vmcnt(0)" ::: "memory");
            const unsigned og = xb_add(&bar[XB_TOP], 1u);
            const unsigned tg = og / nx;
            if (og + 1u == (tg + 1u) * nx) xb_add(&bar[XB_TOPGEN], 1u);
            else XB_SPIN(xb_ld(&bar[XB_TOPGEN]) == tg, bar);
            __builtin_amdgcn_fence(__ATOMIC_ACQUIRE, "agent");
            xb_add(&bar[XB_XGEN(b.x)], 1u);
            asm volatile("s_waitcnt vmcnt(0)" ::: "memory");
        } else {
            XB_SPIN(xb_ld(&bar[XB_XGEN(b.x)]) == gen, bar);
            __builtin_amdgcn_fence(__ATOMIC_ACQUIRE, "agent");
            asm volatile("s_waitcnt vmcnt(0)" ::: "memory");
        }
    }
    __syncthreads();
}

struct Frame {
    LAS unsigned char* lds;
    int tid, lane, wave, vcu, G;
    float* out; unsigned char* ws;
};

__device__ __forceinline__ float wave_sum(float v) {
#pragma unroll
    for (int o = 1; o < 64; o <<= 1) v += __shfl_xor(v, o);
    return v;
}

__device__ __forceinline__ void cvt_load(const float* W, int Nsrc, int k0, int n0, int wave, int lane, f32x4 (&v)[8]) {
#pragma unroll
    for (int rr = 0; rr < 8; ++rr) v[rr] = *(const GAS f32x4*)(W + (size_t)(k0 + wave * 8 + rr) * Nsrc + n0 + 4 * lane);
}
template <class DMap>
__device__ __forceinline__ void cvt_store(Frame& F, const f32x4 (&v)[8], const float* gain, int k0, int n0, bf16* WT, const DMap& dmap) {
    LAS float* scr = (LAS float*)F.lds;
    const int wave = F.wave, lane = F.lane;
#pragma unroll
    for (int rr = 0; rr < 8; ++rr) { const int k = wave * 8 + rr; *(LAS f32x4*)(scr + k * 256 + ((lane ^ wave) & 63) * 4) = v[rr]; }
    __syncthreads();
    const int kg = lane & 7, nl = lane >> 3;
    f32x4 g0 = (f32x4){1.f, 1.f, 1.f, 1.f}, g1 = g0;
    if (gain) { g0 = *(const GAS f32x4*)(gain + k0 + 8 * kg); g1 = *(const GAS f32x4*)(gain + k0 + 8 * kg + 4); }
#pragma unroll
    for (int s = 0; s < 4; ++s) {
        const int n = (s * 8 + wave) * 8 + nl, quad = n >> 2, c = n & 3;
        float e[8];
#pragma unroll
        for (int kk = 0; kk < 8; ++kk) e[kk] = scr[(8 * kg + kk) * 256 + ((quad ^ kg) * 4) + c];
        u32x4 o; o.x = cvt_pk_bf16(e[0] * g0[0], e[1] * g0[1]); o.y = cvt_pk_bf16(e[2] * g0[2], e[3] * g0[3]); o.z = cvt_pk_bf16(e[4] * g1[0], e[5] * g1[1]); o.w = cvt_pk_bf16(e[6] * g1[2], e[7] * g1[3]);
        *(GAS u32x4*)(WT + (size_t)dmap(n0 + n) * 1024 + k0 + 8 * kg) = o;
    }
    __syncthreads();
}
struct MapIdent { int base; __device__ __forceinline__ int operator()(int n) const { return base + n; } };
struct MapInProj { __device__ __forceinline__ int operator()(int n) const { if (n >= 1024) return n; const int s = n >> 9, c = n & 511; return 256 * (c >> 7) + 128 * s + (c & 127); } };
struct MapGU { int s; __device__ __forceinline__ int operator()(int n) const { return 256 * (n >> 7) + 128 * s + (n & 127); } };

constexpr int N_CVT_ITEMS = 96 * 64 + 160 + 64;
struct P0Ptrs { const float *x, *g_mix, *w_in, *w_out, *g_ffn, *w_gate, *w_up, *w_down; };
__device__ __forceinline__ void cvt_item_src(const P0Ptrs& P, int it, const float*& W, int& Nsrc, int& k0, int& n0) {
    if (it < 6144) { const int mat = it >> 6, rem = it & 63, which = mat >> 5, e = mat & 31; const float* wg_ = P.w_gate; const float* wu_ = P.w_up; const float* wd_ = P.w_down; const float* base = wg_; if (which == 1) base = wu_; if (which == 2) base = wd_;
        W = base + (size_t)e * 1024 * 1024; Nsrc = 1024; k0 = (rem >> 2) * 64; n0 = (rem & 3) * 256; }
    else if (it < 6304) { const int r = it - 6144; W = P.w_in; Nsrc = DIN; k0 = (r / 10) * 64; n0 = (r % 10) * 256; }
    else { const int r = it - 6304; W = P.w_out; Nsrc = 1024; k0 = (r >> 2) * 64; n0 = (r & 3) * 256; }
}
__device__ __forceinline__ void cvt_item_store(Frame& F, const P0Ptrs& P, int it, const f32x4 (&v)[8]) {
    if (it < 6144) { const int mat = it >> 6, rem = it & 63, which = mat >> 5, e = mat & 31; const int k0 = (rem >> 2) * 64, n0 = (rem & 3) * 256;
        if (which == 2) cvt_store(F, v, nullptr, k0, n0, (bf16*)(F.ws + WS_WD) + (size_t)e * 1024 * 1024, MapIdent{0});
        else cvt_store(F, v, P.g_ffn, k0, n0, (bf16*)(F.ws + WS_WGU) + (size_t)e * 2048 * 1024, MapGU{which}); }
    else if (it < 6304) { const int r = it - 6144; cvt_store(F, v, P.g_mix, (r / 10) * 64, (r % 10) * 256, (bf16*)(F.ws + WS_WIN), MapInProj{}); }
    else { const int r = it - 6304; cvt_store(F, v, nullptr, (r >> 2) * 64, (r & 3) * 256, (bf16*)(F.ws + WS_WOUT), MapIdent{0}); }
}
__device__ __forceinline__ void p0_prologue(Frame& F, const P0Ptrs& P) {
    { const int gw = F.vcu * 8 + F.wave, NGW = F.G * 8; bf16* XB = (bf16*)(F.ws + WS_XB); float* rs1 = (float*)(F.ws + WS_RS1);
      for (int m = gw; m < T; m += NGW) {
        const GAS f32x4* xr = (const GAS f32x4*)(P.x + (size_t)m * D) + F.lane; f32x4 v[4]; float s = 0.f;
#pragma unroll
        for (int j = 0; j < 4; ++j) { v[j] = xr[64 * j]; s += (v[j].x * v[j].x + v[j].y * v[j].y) + (v[j].z * v[j].z + v[j].w * v[j].w); }
        s = wave_sum(s);
        if (F.lane == 0) rs1[m] = 1.0f / sqrtf(s * (1.0f / D) + EPS);
        GAS u32x2* o8 = (GAS u32x2*)(XB + (size_t)m * D) + F.lane;
#pragma unroll
        for (int j = 0; j < 4; ++j) { u32x2 w; w.x = cvt_pk_bf16(v[j].x, v[j].y); w.y = cvt_pk_bf16(v[j].z, v[j].w); o8[64 * j] = w; }
      } }
    int it = F.vcu; if (it >= N_CVT_ITEMS) return;
    f32x4 cur[8], nxt[8];
    { const float* W; int Nsrc, k0, n0; cvt_item_src(P, it, W, Nsrc, k0, n0); cvt_load(W, Nsrc, k0, n0, F.wave, F.lane, cur); }
    for (;;) {
        int itn = it + F.G; bool more = itn < N_CVT_ITEMS;
        if (more) { const float* W; int Nsrc, k0, n0; cvt_item_src(P, itn, W, Nsrc, k0, n0); cvt_load(W, Nsrc, k0, n0, F.wave, F.lane, nxt); }
        cvt_item_store(F, P, it, cur);
        if (!more) break;
        it = itn; itn = it + F.G; more = itn < N_CVT_ITEMS;
        if (more) { const float* W; int Nsrc, k0, n0; cvt_item_src(P, itn, W, Nsrc, k0, n0); cvt_load(W, Nsrc, k0, n0, F.wave, F.lane, cur); }
        cvt_item_store(F, P, it, nxt);
        if (!more) break;
        it = itn;
    }
}

typedef const f32x4 (&AccRef)[2][2][4][2];
struct EpiInProj {
    const float* rs1; const float* b_in; bf16* U; bf16* Q; bf16* Kk;
    __device__ __forceinline__ void operator()(AccRef acc, const pg8::Unit& u, int wr, int wc, int fr, int fq) const {
        const int row0 = u.pm * 256 + wr * 64 + fr, cl = wc * 32 + 8 * fq;
        if (u.pn < 4) {
            const int ch = 128 * u.pn + cl;
            f32x4 ba[2], bg[2];
#pragma unroll
            for (int n = 0; n < 2; ++n) { ba[n] = *(const GAS f32x4*)(b_in + ch + 4 * n); bg[n] = *(const GAS f32x4*)(b_in + 512 + ch + 4 * n); }
#pragma unroll
            for (int ai = 0; ai < 2; ++ai)
#pragma unroll
                for (int m = 0; m < 4; ++m) { const int row = row0 + ai * 128 + m * 16; const float rs = rs1[row];
                    float o[8];
#pragma unroll
                    for (int n = 0; n < 2; ++n)
#pragma unroll
                        for (int j = 0; j < 4; ++j) { const float a = acc[ai][0][m][n][j] * rs + ba[n][j], g = acc[ai][1][m][n][j] * rs + bg[n][j]; o[4 * n + j] = a * sigmoidf_(g); }
                    u32x4 w; w.x = cvt_pk_bf16(o[0], o[1]); w.y = cvt_pk_bf16(o[2], o[3]); w.z = cvt_pk_bf16(o[4], o[5]); w.w = cvt_pk_bf16(o[6], o[7]);
                    *(GAS u32x4*)(U + (size_t)row * 512 + ch) = w; }
        } else {
            const int t = (u.pn - 4) >> 1; bf16* O = t == 0 ? Q : Kk; const int colt = ((u.pn - 4) & 1) * 256 + cl; const float* bias = b_in + 1024 + 512 * t + colt;
            f32x4 bv[2][2];
#pragma unroll
            for (int bj = 0; bj < 2; ++bj)
#pragma unroll
                for (int n = 0; n < 2; ++n) bv[bj][n] = *(const GAS f32x4*)(bias + bj * 128 + 4 * n);
#pragma unroll
            for (int ai = 0; ai < 2; ++ai)
#pragma unroll
                for (int m = 0; m < 4; ++m) { const int row = row0 + ai * 128 + m * 16; const float rs = rs1[row];
#pragma unroll
                    for (int bj = 0; bj < 2; ++bj) { const f32x4 v0 = acc[ai][bj][m][0] * rs + bv[bj][0], v1 = acc[ai][bj][m][1] * rs + bv[bj][1];
                        u32x4 w; w.x = cvt_pk_bf16(v0[0], v0[1]); w.y = cvt_pk_bf16(v0[2], v0[3]); w.z = cvt_pk_bf16(v1[0], v1[1]); w.w = cvt_pk_bf16(v1[2], v1[3]);
                        *(GAS u32x4*)(O + (size_t)row * 512 + colt + bj * 128) = w; } }
        }
    }
};
struct EpiVt {
    const float* rs1; const float* b_v; bf16* Vt;
    __device__ __forceinline__ void operator()(AccRef acc, const pg8::Unit& u, int wr, int wc, int fr, int fq) const {
        const int c0 = u.pm * 256 + wr * 64 + fr, t0 = u.pn * 256 + wc * 32 + 8 * fq;
        f32x4 rv[2][2];
#pragma unroll
        for (int bj = 0; bj < 2; ++bj)
#pragma unroll
            for (int n = 0; n < 2; ++n) rv[bj][n] = *(const GAS f32x4*)(rs1 + t0 + bj * 128 + 4 * n);
#pragma unroll
        for (int ai = 0; ai < 2; ++ai)
#pragma unroll
            for (int m = 0; m < 4; ++m) { const int c = c0 + ai * 128 + m * 16; const float bb = b_v[c];
#pragma unroll
                for (int bj = 0; bj < 2; ++bj) { const int t = t0 + bj * 128; const f32x4 v0 = acc[ai][bj][m][0] * rv[bj][0] + bb, v1 = acc[ai][bj][m][1] * rv[bj][1] + bb;
                    u32x4 w; w.x = cvt_pk_bf16(v0[0], v0[1]); w.y = cvt_pk_bf16(v0[2], v0[3]); w.z = cvt_pk_bf16(v1[0], v1[1]); w.w = cvt_pk_bf16(v1[2], v1[3]);
                    *(GAS u32x4*)(Vt + ((size_t)((t >> 6) * 8 + (c >> 6)) * 64 + (c & 63)) * 64 + (t & 63)) = w; } }
    }
};
struct EpiOut {
    const float* x; const float* b_out; float* h; bf16* hb; float* ssq;
    __device__ __forceinline__ void operator()(AccRef acc, const pg8::Unit& u, int wr, int wc, int fr, int fq) const {
        const int row0 = u.pm * 256 + wr * 64 + fr, col0 = u.pn * 256 + wc * 32 + 8 * fq;
        f32x4 bv[2][2];
#pragma unroll
        for (int bj = 0; bj < 2; ++bj)
#pragma unroll
            for (int n = 0; n < 2; ++n) bv[bj][n] = *(const GAS f32x4*)(b_out + col0 + bj * 128 + 4 * n);
#pragma unroll
        for (int ai = 0; ai < 2; ++ai)
#pragma unroll
            for (int m = 0; m < 4; ++m) { const int row = row0 + ai * 128 + m * 16; const size_t off = (size_t)row * D + col0; float s = 0.f;
#pragma unroll
                for (int bj = 0; bj < 2; ++bj) {
                    const f32x4 x0 = *(const GAS f32x4*)(x + off + bj * 128), x1 = *(const GAS f32x4*)(x + off + bj * 128 + 4);
                    const f32x4 v0 = acc[ai][bj][m][0] + bv[bj][0] + x0, v1 = acc[ai][bj][m][1] + bv[bj][1] + x1;
                    s += (v0[0] * v0[0] + v0[1] * v0[1]) + (v0[2] * v0[2] + v0[3] * v0[3]) + (v1[0] * v1[0] + v1[1] * v1[1]) + (v1[2] * v1[2] + v1[3] * v1[3]);
                    *(GAS f32x4*)(h + off + bj * 128) = v0; *(GAS f32x4*)(h + off + bj * 128 + 4) = v1;
                    u32x4 w; w.x = cvt_pk_bf16(v0[0], v0[1]); w.y = cvt_pk_bf16(v0[2], v0[3]); w.z = cvt_pk_bf16(v1[0], v1[1]); w.w = cvt_pk_bf16(v1[2], v1[3]);
                    *(GAS u32x4*)(hb + off + bj * 128) = w; }
                s += __shfl_xor(s, 16); s += __shfl_xor(s, 32);
                if (fq == 0) ssq[(size_t)row * 16 + u.pn * 4 + wc] = s; }
    }
};
struct EpiGU {
    const pg8::GroupedOrder<true>* S; const LAS float* rowf; const float* b_gate; const float* b_up; bf16* HD;
    __device__ __forceinline__ void operator()(AccRef acc, const pg8::Unit& u, int wr, int wc, int fr, int fq) const {
        int ue, urow0, unvalid; S->meta(u, ue, urow0, unvalid);
        const int rl0 = wr * 64 + fr, ch = 128 * u.pn + wc * 32 + 8 * fq;
        f32x4 bg[2], bu[2];
#pragma unroll
        for (int n = 0; n < 2; ++n) { bg[n] = *(const GAS f32x4*)(b_gate + ue * DFF + ch + 4 * n); bu[n] = *(const GAS f32x4*)(b_up + ue * DFF + ch + 4 * n); }
#pragma unroll
        for (int ai = 0; ai < 2; ++ai)
#pragma unroll
            for (int m = 0; m < 4; ++m) { const int rl = rl0 + ai * 128 + m * 16; const float rs = rowf[u.slot * 256 + rl];
                float o[8];
#pragma unroll
                for (int n = 0; n < 2; ++n)
#pragma unroll
                    for (int j = 0; j < 4; ++j) { float gt = acc[ai][0][m][n][j] * rs + bg[n][j], up = acc[ai][1][m][n][j] * rs + bu[n][j];
                        gt = fminf(gt, 7.0f); up = fminf(fmaxf(up, -7.0f), 7.0f);
                        o[4 * n + j] = (up + 1.0f) * gt * fast_rcp(1.0f + fast_exp2(-1.702f * LOG2E * gt)); }
                if (rl < unvalid) { u32x4 w; w.x = cvt_pk_bf16(o[0], o[1]); w.y = cvt_pk_bf16(o[2], o[3]); w.z = cvt_pk_bf16(o[4], o[5]); w.w = cvt_pk_bf16(o[6], o[7]);
                    *(GAS u32x4*)(HD + (size_t)(urow0 + rl) * DFF + ch) = w; } }
    }
};
struct EpiDown {
    const pg8::GroupedOrder<false>* S; const LAS float* rowf; const float* b_down; bf16* Y;
    __device__ __forceinline__ void operator()(AccRef acc, const pg8::Unit& u, int wr, int wc, int fr, int fq) const {
        int ue, urow0, unvalid; S->meta(u, ue, urow0, unvalid);
        const int rl0 = wr * 64 + fr, col0 = u.pn * 256 + wc * 32 + 8 * fq;
        f32x4 bv[2][2];
#pragma unroll
        for (int bj = 0; bj < 2; ++bj)
#pragma unroll
            for (int n = 0; n < 2; ++n) bv[bj][n] = *(const GAS f32x4*)(b_down + ue * D + col0 + bj * 128 + 4 * n);
#pragma unroll
        for (int ai = 0; ai < 2; ++ai)
#pragma unroll
            for (int m = 0; m < 4; ++m) { const int rl = rl0 + ai * 128 + m * 16; const float gt = rowf[u.slot * 256 + rl];
                if (rl < unvalid) {
#pragma unroll
                    for (int bj = 0; bj < 2; ++bj) { const f32x4 v0 = (acc[ai][bj][m][0] + bv[bj][0]) * gt, v1 = (acc[ai][bj][m][1] + bv[bj][1]) * gt;
                        u32x4 w; w.x = cvt_pk_bf16(v0[0], v0[1]); w.y = cvt_pk_bf16(v0[2], v0[3]); w.z = cvt_pk_bf16(v1[0], v1[1]); w.w = cvt_pk_bf16(v1[2], v1[3]);
                        *(GAS u32x4*)(Y + (size_t)(urow0 + rl) * D + col0 + bj * 128) = w; } } }
    }
};

constexpr int CV_T = 32, CV_ROWS = CV_T + 30;
constexpr int CV_IN = 0, CV_OUT = 65536;
__device__ __forceinline__ void conv_unit(Frame& F, const float* ln_g, const float* ln_b, int t0, const float (&w0)[31], const float (&w1)[31], float cb0, float cb1) {
    const bf16* U = (const bf16*)(F.ws + WS_U); bf16* MIX = (bf16*)(F.ws + WS_MIX);
    LAS unsigned char* lin = F.lds + CV_IN; LAS float* lout = (LAS float*)(F.lds + CV_OUT);
    for (int p = F.tid; p < CV_ROWS * 64; p += 512) { const int r = p >> 6, c = p & 63; const int t = t0 - 15 + r;
        u32x4 v = (u32x4){0u, 0u, 0u, 0u}; if (t >= 0 && t < T) v = *(const GAS u32x4*)(U + (size_t)t * 512 + c * 8);
        *(LAS u32x4*)(lin + r * 1024 + c * 16) = v; }
    __syncthreads();
    { const int p = F.tid & 255, q = F.tid >> 8;
      float o0[16], o1[16];
#pragma unroll
      for (int i = 0; i < 16; ++i) { o0[i] = cb0; o1[i] = cb1; }
#pragma unroll
      for (int r = 0; r < 46; ++r) { const unsigned wv = *(const LAS unsigned*)(lin + (16 * q + r) * 1024 + p * 4); const float x0 = bf_lo(wv), x1 = bf_hi(wv);
#pragma unroll
          for (int i = 0; i < 16; ++i) { const int j = r - i; if (j >= 0 && j < 31) { o0[i] += x0 * w0[j]; o1[i] += x1 * w1[j]; } } }
#pragma unroll
      for (int i = 0; i < 16; ++i) *(LAS f32x2*)(lout + (16 * q + i) * 512 + 2 * p) = (f32x2){o0[i], o1[i]};
    }
    __syncthreads();
#pragma unroll 1
    for (int tt = 0; tt < 4; ++tt) { const int tl = F.wave * 4 + tt;
        const f32x4 a = *(const LAS f32x4*)(lout + tl * 512 + 4 * F.lane), b = *(const LAS f32x4*)(lout + tl * 512 + 256 + 4 * F.lane);
        float s = (a[0] + a[1]) + (a[2] + a[3]) + (b[0] + b[1]) + (b[2] + b[3]); s = wave_sum(s); const float mu = s * (1.0f / 512.0f);
        const f32x4 da = a - mu, db = b - mu; float q2 = (da[0] * da[0] + da[1] * da[1]) + (da[2] * da[2] + da[3] * da[3]) + (db[0] * db[0] + db[1] * db[1]) + (db[2] * db[2] + db[3] * db[3]);
        q2 = wave_sum(q2); const float rstd = 1.0f / sqrtf(q2 * (1.0f / 512.0f) + EPS);
        const f32x4 ga = *(const GAS f32x4*)(ln_g + 4 * F.lane), gb = *(const GAS f32x4*)(ln_g + 256 + 4 * F.lane), ba = *(const GAS f32x4*)(ln_b + 4 * F.lane), bb = *(const GAS f32x4*)(ln_b + 256 + 4 * F.lane);
        f32x4 ya = da * rstd * ga + ba, yb = db * rstd * gb + bb;
#pragma unroll
        for (int j = 0; j < 4; ++j) { ya[j] = ya[j] * sigmoidf_(ya[j]); yb[j] = yb[j] * sigmoidf_(yb[j]); }
        u32x2 wa, wb; wa.x = cvt_pk_bf16(ya[0], ya[1]); wa.y = cvt_pk_bf16(ya[2], ya[3]); wb.x = cvt_pk_bf16(yb[0], yb[1]); wb.y = cvt_pk_bf16(yb[2], yb[3]);
        bf16* orow = MIX + (size_t)(t0 + tl) * D;
        *(GAS u32x2*)(orow + 4 * F.lane) = wa; *(GAS u32x2*)(orow + 256 + 4 * F.lane) = wb; }
    __syncthreads();
}

__device__ __forceinline__ void attn_item(Frame& F, int i, int n, int h, const LAS float* rpbL) {
    const bf16* Q = (const bf16*)(F.ws + WS_Q); const bf16* Kp = (const bf16*)(F.ws + WS_K); const bf16* Vt = (const bf16*)(F.ws + WS_VT); bf16* MIX = (bf16*)(F.ws + WS_MIX);
    const int lane = F.lane, q = lane & 15, G = lane >> 4;
    const int qc = 16 * n + q, tokq = i * 64 + qc;
    const int r0 = min(max(i - 4, 0), NROWS - 8), bs = min(max(16 * n - 8, 0), 32);
    const bf16* qp = Q + (size_t)tokq * 512 + h * 64 + 8 * G;
    const bf16x8 Qf0 = *(const GAS bf16x8*)qp, Qf1 = *(const GAS bf16x8*)(qp + 32);
    const int kcl = 8 * (q >> 2) + (q & 3);
    bf16x8 Kf[8][2][2];
#pragma unroll
    for (int s = 0; s < 8; ++s)
#pragma unroll
        for (int odd = 0; odd < 2; ++odd) {
            const int tok = (r0 + s) * 64 + bs + kcl + 4 * odd; const bf16* kp = Kp + (size_t)tok * 512 + h * 64 + 8 * G;
            Kf[s][odd][0] = *(const GAS bf16x8*)kp; Kf[s][odd][1] = *(const GAS bf16x8*)(kp + 32); }
    __builtin_amdgcn_sched_barrier(0);
    f32x4 S[8][2];
#pragma unroll
    for (int s = 0; s < 8; ++s)
#pragma unroll
        for (int odd = 0; odd < 2; ++odd) {
            f32x4 a = (f32x4){0.f, 0.f, 0.f, 0.f};
            a = __builtin_amdgcn_mfma_f32_16x16x32_bf16(Kf[s][odd][0], Qf0, a, 0, 0, 0); a = __builtin_amdgcn_mfma_f32_16x16x32_bf16(Kf[s][odd][1], Qf1, a, 0, 0, 0);
            S[s][odd] = a; }
    bf16x8 Vf[4][4];
#pragma unroll
    for (int s = 0; s < 4; ++s) { const bf16* vb = Vt + ((size_t)((r0 + s) * 8 + h) * 64 + q) * 64 + bs + 8 * G;
#pragma unroll
        for (int d = 0; d < 4; ++d) Vf[s][d] = *(const GAS bf16x8*)(vb + d * 16 * 64); }
    __builtin_amdgcn_sched_barrier(0);
    const int c0 = min(max(qc - 8, 0), GRIDW - 16);
    const LAS float* rb = rpbL + h * 465;
    float mx = -1e30f;
#pragma unroll
    for (int s = 0; s < 8; ++s) { const int drow = r0 + s - i + 7;
#pragma unroll
        for (int odd = 0; odd < 2; ++odd)
#pragma unroll
            for (int r = 0; r < 4; ++r) { const int kc = bs + 8 * G + 4 * odd + r; const bool valid = (kc >= c0) && (kc < c0 + 16);
                const int dcol = min(max(kc - qc, -15), 15) + 15;
                float t = S[s][odd][r] * (0.125f * LOG2E) + rb[drow * 31 + dcol]; t = valid ? t : -1e30f; S[s][odd][r] = t; mx = fmaxf(mx, t); } }
    mx = fmaxf(mx, __shfl_xor(mx, 16)); mx = fmaxf(mx, __shfl_xor(mx, 32));
    float l = 0.f; bf16x8 Pf[8];
#pragma unroll
    for (int s = 0; s < 8; ++s) { float p[8];
#pragma unroll
        for (int odd = 0; odd < 2; ++odd)
#pragma unroll
            for (int r = 0; r < 4; ++r) { const float e = fast_exp2(S[s][odd][r] - mx); p[4 * odd + r] = e; l += e; }
        u32x4 w; w.x = cvt_pk_bf16(p[0], p[1]); w.y = cvt_pk_bf16(p[2], p[3]); w.z = cvt_pk_bf16(p[4], p[5]); w.w = cvt_pk_bf16(p[6], p[7]);
        Pf[s] = __builtin_bit_cast(bf16x8, w); }
    l += __shfl_xor(l, 16); l += __shfl_xor(l, 32);
    const float inv = 1.0f / l;
    f32x4 O[4];
#pragma unroll
    for (int d = 0; d < 4; ++d) O[d] = (f32x4){0.f, 0.f, 0.f, 0.f};
    bf16x8 Vg[4][4];
#pragma unroll
    for (int s = 0; s < 4; ++s) { const bf16* vb = Vt + ((size_t)((r0 + 4 + s) * 8 + h) * 64 + q) * 64 + bs + 8 * G;
#pragma unroll
        for (int d = 0; d < 4; ++d) Vg[s][d] = *(const GAS bf16x8*)(vb + d * 16 * 64); }
    __builtin_amdgcn_sched_barrier(0);
#pragma unroll
    for (int s = 0; s < 4; ++s)
#pragma unroll
        for (int d = 0; d < 4; ++d) O[d] = __builtin_amdgcn_mfma_f32_16x16x32_bf16(Vf[s][d], Pf[s], O[d], 0, 0, 0);
#pragma unroll
    for (int s = 0; s < 4; ++s)
#pragma unroll
        for (int d = 0; d < 4; ++d) O[d] = __builtin_amdgcn_mfma_f32_16x16x32_bf16(Vg[s][d], Pf[4 + s], O[d], 0, 0, 0);
    bf16* orow = MIX + (size_t)tokq * D + 512 + h * 64 + 4 * G;
#pragma unroll
    for (int d = 0; d < 4; ++d) { u32x2 w; w.x = cvt_pk_bf16(O[d][0] * inv, O[d][1] * inv); w.y = cvt_pk_bf16(O[d][2] * inv, O[d][3] * inv); *(GAS u32x2*)(orow + 16 * d) = w; }
}

__device__ __forceinline__ void p2_mixer(Frame& F, const float* conv_w, const float* conv_b, const float* ln_g, const float* ln_b, const float* rpb) {
    { const int p = F.tid & 255; float w0[31], w1[31];
#pragma unroll
      for (int j = 0; j < 31; ++j) { const f32x2 wv = *(const GAS f32x2*)(conv_w + j * 512 + 2 * p); w0[j] = wv.x; w1[j] = wv.y; }
      const f32x2 cb = *(const GAS f32x2*)(conv_b + 2 * p);
      for (int row = F.vcu; row < NROWS; row += F.G) { conv_unit(F, ln_g, ln_b, row * 64, w0, w1, cb.x, cb.y); conv_unit(F, ln_g, ln_b, row * 64 + 32, w0, w1, cb.x, cb.y); } }
    LAS float* rpbL = (LAS float*)F.lds;
    for (int p = F.tid; p < NHEAD * 465; p += 512) rpbL[p] = rpb[p] * LOG2E;
    __syncthreads();
    for (int row = F.vcu; row < NROWS; row += F.G)
#pragma unroll 1
        for (int n = 0; n < 4; ++n) attn_item(F, row, n, F.wave, rpbL);
    __syncthreads();
}

constexpr int RT_W = 0;
constexpr int RT_LOGIT = 73728;
constexpr int RT_HIST = RT_LOGIT + 8192;
__device__ __forceinline__ void p4_router(Frame& F, const float* w_router, const float* g_ffn, const float* b_router) {
    const float* h = F.out; const float* ssq = (const float*)(F.ws + WS_SSQ); float* rs2 = (float*)(F.ws + WS_RS2);
    unsigned* erank = (unsigned*)(F.ws + WS_ERANK); int* list = (int*)(F.ws + WS_LIST); float* glist = (float*)(F.ws + WS_GLIST);
    unsigned* gcount = (unsigned*)(F.ws + WS_CTL) + CW_GCOUNT;
    LAS float* wl = (LAS float*)(F.lds + RT_W); LAS float* logitL = (LAS float*)(F.lds + RT_LOGIT); LAS unsigned* hist = (LAS unsigned*)(F.lds + RT_HIST);
    const int lane = F.lane, th = lane >> 5, ks = lane & 31, g4 = lane >> 4, k16 = lane & 15;
    for (int blk = F.vcu; blk < T / 64; blk += F.G) {
        const int tb = blk * 64 + F.wave * 8 + th * 4;
        const int tg = blk * 64 + F.wave * 8 + g4 * 2;
        float acc[2][32];
#pragma unroll
        for (int a = 0; a < 2; ++a)
#pragma unroll
            for (int e = 0; e < 32; ++e) acc[a][e] = 0.f;
#pragma unroll 1
        for (int hf = 0; hf < 2; ++hf) {
            __syncthreads();
            for (int idx = F.tid; idx < 512 * 32; idx += 512) { const int kk = idx >> 5, e = idx & 31; wl[kk * 36 + e] = w_router[(size_t)(hf * 512 + kk) * 32 + e] * g_ffn[hf * 512 + kk]; }
            if (F.tid < 64) hist[F.tid] = 0u;
            __syncthreads();
#pragma unroll 1
            for (int cc = 0; cc < 8; ++cc) { const int kb = 4 * (k16 + 16 * cc);
                const f32x4 h0 = *(const GAS f32x4*)(h + (size_t)tg * D + hf * 512 + kb), h1 = *(const GAS f32x4*)(h + (size_t)(tg + 1) * D + hf * 512 + kb);
#pragma unroll
                for (int c = 0; c < 4; ++c) {
#pragma unroll
                    for (int e4 = 0; e4 < 8; ++e4) { const f32x4 w = *(const LAS f32x4*)(wl + (kb + c) * 36 + 4 * e4);
#pragma unroll
                        for (int j = 0; j < 4; ++j) { acc[0][4 * e4 + j] += h0[c] * w[j]; acc[1][4 * e4 + j] += h1[c] * w[j]; } } } }
        }
        float r32[32], r16[16], r8[8], r4[4];
#pragma unroll
        for (int i = 0; i < 32; ++i) { const bool up = (lane & 8) != 0; const float send = up ? acc[0][i] : acc[1][i], keep = up ? acc[1][i] : acc[0][i]; r32[i] = keep + __shfl_xor(send, 8); }
#pragma unroll
        for (int i = 0; i < 16; ++i) { const bool up = (lane & 4) != 0; const float send = up ? r32[i] : r32[i + 16], keep = up ? r32[i + 16] : r32[i]; r16[i] = keep + __shfl_xor(send, 4); }
#pragma unroll
        for (int i = 0; i < 8; ++i) { const bool up = (lane & 2) != 0; const float send = up ? r16[i] : r16[i + 8], keep = up ? r16[i + 8] : r16[i]; r8[i] = keep + __shfl_xor(send, 2); }
#pragma unroll
        for (int i = 0; i < 4; ++i) { const bool up = (lane & 1) != 0; const float send = up ? r8[i] : r8[i + 4], keep = up ? r8[i + 4] : r8[i]; r4[i] = keep + __shfl_xor(send, 1); }
        *(LAS f32x4*)(logitL + (F.wave * 8 + g4 * 2 + (k16 >> 3)) * 32 + 4 * (k16 & 7)) = (f32x4){r4[0], r4[1], r4[2], r4[3]};
        LDS_WAIT(); asm volatile("" ::: "memory");
        int myE[4]; float myG[4]; unsigned myR[4];
#pragma unroll
        for (int a = 0; a < 4; ++a) { const int tok = tb + a;
            float sp = ks < 16 ? ssq[(size_t)tok * 16 + ks] : 0.f;
#pragma unroll
            for (int o = 1; o < 16; o <<= 1) sp += __shfl_xor(sp, o);
            sp = __shfl(sp, lane & 32);
            const float rs = 1.0f / sqrtf(sp * (1.0f / D) + EPS);
            if (ks == 0) rs2[tok] = rs;
            const float v = logitL[(F.wave * 8 + th * 4 + a) * 32 + ks] * rs + b_router[ks];
            bool taken = false; float tv[4]; int ti[4];
#pragma unroll
            for (int r = 0; r < 4; ++r) { float bv = taken ? -3.0e38f : v; int bi = ks;
#pragma unroll
                for (int o = 1; o < 32; o <<= 1) { const float ov = __shfl_xor(bv, o); const int oi = __shfl_xor(bi, o); if (ov > bv || (ov == bv && oi < bi)) { bv = ov; bi = oi; } }
                tv[r] = bv; ti[r] = bi; if (bi == ks) taken = true; }
            const float e1 = __expf(tv[1] - tv[0]), e2 = __expf(tv[2] - tv[0]), e3 = __expf(tv[3] - tv[0]); const float inv = 1.0f / (1.0f + e1 + e2 + e3);
            const float gsel = ks == 0 ? inv : (ks == 1 ? e1 * inv : (ks == 2 ? e2 * inv : e3 * inv)); const int esel = ks == 0 ? ti[0] : (ks == 1 ? ti[1] : (ks == 2 ? ti[2] : ti[3]));
            myE[a] = esel; myG[a] = gsel; myR[a] = 0u;
            if (ks < 4) myR[a] = __hip_atomic_fetch_add(hist + esel, 1u, __ATOMIC_RELAXED, __HIP_MEMORY_SCOPE_WORKGROUP); }
        __syncthreads();
        if (F.tid < 32) hist[32 + F.tid] = __hip_atomic_fetch_add(gcount + F.tid, hist[F.tid], RLX_AGENT);
        __syncthreads();
        if (ks < 4) {
#pragma unroll
            for (int a = 0; a < 4; ++a) { const unsigned rank = hist[32 + myE[a]] + myR[a]; const int tok = tb + a;
                list[myE[a] * 16384 + rank] = tok; glist[myE[a] * 16384 + rank] = myG[a]; erank[tok * 4 + ks] = ((unsigned)myE[a] << 16) | rank; } }
    }
    __syncthreads();
}

__device__ __forceinline__ int grouped_setup(Frame& F, int ntn, bool gate_mode) {
    LAS int* tile = (LAS int*)(F.lds + AT_TILE); LAS int* offs = (LAS int*)(F.lds + AT_OFFS);
    LAS unsigned* tokoff = (LAS unsigned*)(F.lds + AT_TOK); LAS float* rowf = (LAS float*)(F.lds + AT_ROWF);
    const unsigned* gcount = (const unsigned*)(F.ws + WS_CTL) + CW_GCOUNT;
    const int* list = (const int*)(F.ws + WS_LIST); const float* glist = (const float*)(F.ws + WS_GLIST); const float* rs2 = (const float*)(F.ws + WS_RS2);
    __syncthreads();
    if (F.tid == 0) { int o = 0, nt = 0;
        for (int e = 0; e < NE; ++e) { const int c = (int)gcount[e]; offs[e] = o; offs[33 + e] = c; o += c; const int k = (c + 255) >> 8; for (int j = 0; j < k; ++j) tile[nt++] = (e << 16) | j; }
        offs[32] = o; offs[70] = nt; }
    __syncthreads();
    const int ntiles = offs[70];
    for (int i = 0; i < MAXU; ++i) { const int L = i * F.G + (int)blockIdx.x; if (L >= ntiles * ntn) break;
        const int mt = L / ntn, te = tile[mt], e = te >> 16, j = te & 0xffff, cnt = offs[33 + e];
        for (int r = F.tid; r < 256; r += 512) { const int pos = 256 * j + r; const bool ok = pos < cnt;
            if (gate_mode) rowf[i * 256 + r] = ok ? glist[e * 16384 + pos] : 0.f;
            else { const int tok = ok ? list[e * 16384 + pos] : 0; tokoff[i * 256 + r] = (unsigned)tok * (unsigned)(D * 2); rowf[i * 256 + r] = rs2[tok]; } } }
    __syncthreads();
    return ntiles;
}

__device__ __forceinline__ void p7_combine(Frame& F, const float* g_final) {
    const unsigned* gcount = (const unsigned*)(F.ws + WS_CTL) + CW_GCOUNT; const unsigned* erank = (const unsigned*)(F.ws + WS_ERANK); const bf16* Y = (const bf16*)(F.ws + WS_Y);
    LAS int* offs = (LAS int*)(F.lds + AT_OFFS);
    __syncthreads();
    if (F.tid == 0) { int o = 0; for (int e = 0; e < NE; ++e) { offs[e] = o; o += (int)gcount[e]; } }
    __syncthreads();
    const int gw = F.vcu * 8 + F.wave, NGW = F.G * 8;
    f32x4 gf[4];
#pragma unroll
    for (int j = 0; j < 4; ++j) gf[j] = *(const GAS f32x4*)(g_final + 4 * F.lane + 256 * j);
    for (int t = gw; t < T; t += NGW) {
        const u32x4 er = *(const GAS u32x4*)(erank + t * 4);
        size_t pos[4];
        pos[0] = (size_t)(offs[er.x >> 16] + (int)(er.x & 0xffffu)); pos[1] = (size_t)(offs[er.y >> 16] + (int)(er.y & 0xffffu));
        pos[2] = (size_t)(offs[er.z >> 16] + (int)(er.z & 0xffffu)); pos[3] = (size_t)(offs[er.w >> 16] + (int)(er.w & 0xffffu));
        float* orow = F.out + (size_t)t * D;
        f32x4 v[4]; float s = 0.f;
#pragma unroll
        for (int j = 0; j < 4; ++j) { v[j] = *(const GAS f32x4*)(orow + 4 * F.lane + 256 * j);
#pragma unroll
            for (int r = 0; r < 4; ++r) { const u32x2 y = *(const GAS u32x2*)(Y + pos[r] * D + 4 * F.lane + 256 * j); v[j][0] += bf_lo(y.x); v[j][1] += bf_hi(y.x); v[j][2] += bf_lo(y.y); v[j][3] += bf_hi(y.y); }
            s += (v[j][0] * v[j][0] + v[j][1] * v[j][1]) + (v[j][2] * v[j][2] + v[j][3] * v[j][3]); }
        s = wave_sum(s); const float rs = 1.0f / sqrtf(s * (1.0f / D) + EPS);
#pragma unroll
        for (int j = 0; j < 4; ++j) *(GAS f32x4*)(orow + 4 * F.lane + 256 * j) = v[j] * rs * gf[j];
    }
}

constexpr int NPHASE = 8;
struct Args { const float* in[21]; float* out; unsigned char* ws; int ph_lo, ph_hi; };
__global__ void __launch_bounds__(512, 2) enc_fwd(Args args) {
    extern __shared__ __attribute__((aligned(16))) unsigned char lds[];
    Frame F;
    F.lds = (LAS unsigned char*)lds;
    F.tid = threadIdx.x; F.lane = F.tid & 63; F.wave = __builtin_amdgcn_readfirstlane(F.tid >> 6);
    F.G = gridDim.x; { const int bx = blockIdx.x; F.vcu = (F.G % 8 == 0) ? (bx % 8) * (F.G / 8) + bx / 8 : bx; }
    F.out = args.out; F.ws = args.ws;
    volatile LAS unsigned* MISC = (volatile LAS unsigned*)(F.lds + MISC_OFF);
    if (F.tid < 64) MISC[F.tid] = 0u;
    __syncthreads();
    const int lo = args.ph_lo, hi = args.ph_hi;
    const bool use_bar = (hi - lo) > 1;
    XcdBarrier bar; bar.bar = (unsigned*)(F.ws + WS_CTL) + CW_BAR; bar.x = 0; bar.st = nullptr;
    if (use_bar) bar = xcd_barrier_post((unsigned*)(F.ws + WS_CTL) + CW_BAR, MISC + 8);
#ifndef PH_MASK
#define PH_MASK 0xff
#endif
#define IN(k) (((PH_MASK >> (k)) & 1) && lo <= (k) && (k) < hi)
#define SEAM(k) do { if (IN(k) && IN((k) + 1)) xcd_barrier(bar); } while (0)

    if (IN(0)) { P0Ptrs P{args.in[0], args.in[1], args.in[2], args.in[9], args.in[11], args.in[14], args.in[16], args.in[18]}; p0_prologue(F, P); SEAM(0); }

    if (IN(1)) {
        { pg8::StaticOrder S; S.init(F.ws + WS_XB, F.ws + WS_WIN, T, 2048, D, F.G, (int)blockIdx.x);
          EpiInProj E{(const float*)(F.ws + WS_RS1), args.in[3], (bf16*)(F.ws + WS_U), (bf16*)(F.ws + WS_Q), (bf16*)(F.ws + WS_K)};
          pg8::gemm_phase<EpiInProj, pg8::StaticOrder>(F.lds, D, S, E); }
        { pg8::StaticOrder S; S.init(F.ws + WS_WIN + (size_t)2048 * D * 2, F.ws + WS_XB, 512, T, D, F.G, (int)blockIdx.x);
          EpiVt E{(const float*)(F.ws + WS_RS1), args.in[3] + 2048, (bf16*)(F.ws + WS_VT)};
          pg8::gemm_phase<EpiVt, pg8::StaticOrder>(F.lds, D, S, E); }
        SEAM(1);
    }

    if (IN(2)) { p2_mixer(F, args.in[4], args.in[5], args.in[6], args.in[7], args.in[8]); SEAM(2); }

    if (IN(3)) {
        pg8::StaticOrder S; S.init(F.ws + WS_MIX, F.ws + WS_WOUT, T, D, D, F.G, (int)blockIdx.x);
        EpiOut E{args.in[0], args.in[10], F.out, (bf16*)(F.ws + WS_HB), (float*)(F.ws + WS_SSQ)};
        pg8::gemm_phase<EpiOut, pg8::StaticOrder>(F.lds, D, S, E);
        SEAM(3);
    }

    if (IN(4)) { p4_router(F, args.in[12], args.in[11], args.in[13]); SEAM(4); }

    if (IN(5)) {
        const int ntiles = grouped_setup(F, 8, false);
        pg8::GroupedOrder<true> S; S.A = (const char*)(F.ws + WS_HB); S.Bt = (const char*)(F.ws + WS_WGU); S.K = D; S.ntn = 8; S.Nexp = 2048; S.G = F.G; S.c = (int)blockIdx.x; S.ntiles = ntiles;
        S.tile = (const LAS int*)(F.lds + AT_TILE); S.offs = (const LAS int*)(F.lds + AT_OFFS); S.tokoff = (const LAS unsigned*)(F.lds + AT_TOK);
        EpiGU E{&S, (const LAS float*)(F.lds + AT_ROWF), args.in[15], args.in[17], (bf16*)(F.ws + WS_HD)};
        pg8::gemm_phase<EpiGU, pg8::GroupedOrder<true>>(F.lds, D, S, E);
        SEAM(5);
    }

    if (IN(6)) {
        const int ntiles = grouped_setup(F, 4, true);
        pg8::GroupedOrder<false> S; S.A = (const char*)(F.ws + WS_HD); S.Bt = (const char*)(F.ws + WS_WD); S.K = DFF; S.ntn = 4; S.Nexp = 1024; S.G = F.G; S.c = (int)blockIdx.x; S.ntiles = ntiles;
        S.tile = (const LAS int*)(F.lds + AT_TILE); S.offs = (const LAS int*)(F.lds + AT_OFFS); S.tokoff = (const LAS unsigned*)(F.lds + AT_TOK);
        EpiDown E{&S, (const LAS float*)(F.lds + AT_ROWF), args.in[19], (bf16*)(F.ws + WS_Y)};
        pg8::gemm_phase<EpiDown, pg8::GroupedOrder<false>>(F.lds, DFF, S, E);
        SEAM(6);
    }

    if (IN(7)) { p7_combine(F, args.in[20]); }
#undef IN
#undef SEAM
}

extern "C" void kernel_launch(void* const* d_in, const int* in_sizes, int n_in, void* d_out, int out_size, void* d_ws, size_t ws_size, hipStream_t stream) {
    static int grid = 0;
    if (grid == 0) {
        if (n_in != 21 || out_size != T * D || ws_size < WS_END) { fprintf(stderr, "kernel_launch: unexpected problem (n_in %d, out %d, ws %zu)\n", n_in, out_size, ws_size); grid = -1; return; }
        int dev = 0, cus = 0, per_cu = 0;
        if (hipGetDevice(&dev) != hipSuccess || hipDeviceGetAttribute(&cus, hipDeviceAttributeMultiprocessorCount, dev) != hipSuccess) { grid = -1; return; }
        if (hipFuncSetAttribute((const void*)enc_fwd, hipFuncAttributeMaxDynamicSharedMemorySize, LDS_BYTES) != hipSuccess) { fprintf(stderr, "kernel_launch: cannot set %d bytes of dynamic LDS\n", LDS_BYTES); grid = -1; return; }
        if (hipOccupancyMaxActiveBlocksPerMultiprocessor(&per_cu, (const void*)enc_fwd, 512, LDS_BYTES) != hipSuccess || per_cu < 1) { fprintf(stderr, "kernel_launch: occupancy query says %d\n", per_cu); (void)hipGetLastError(); per_cu = 1; }
        grid = cus;
        if (grid != 256) { fprintf(stderr, "kernel_launch: built for a 256-CU device, got %d CUs\n", cus); grid = -1; return; }
    }
    if (grid < 0) return;
    (void)hipMemsetAsync((char*)d_ws + WS_CTL, 0, CTL_ZERO_BYTES, stream);
    Args a{};
    for (int i = 0; i < 21; ++i) a.in[i] = (const float*)d_in[i];
    a.out = (float*)d_out; a.ws = (unsigned char*)d_ws;
    if (MK_N_LAUNCHES == 1) { a.ph_lo = 0; a.ph_hi = NPHASE; hipLaunchKernelGGL(enc_fwd, dim3(grid), dim3(512), LDS_BYTES, stream, a); }
    else { for (int p = 0; p < NPHASE; ++p) { a.ph_lo = p; a.ph_hi = p + 1; hipLaunchKernelGGL(enc_fwd, dim3(grid), dim3(512), LDS_BYTES, stream, a); } }
}
```

```cpp
#include <hip/hip_runtime.h>
#include <cstdio>
#include <cstdint>

#ifndef MK_N_LAUNCHES
#define MK_N_LAUNCHES 1
#endif

#define GAS __attribute__((address_space(1)))
#define LAS __attribute__((address_space(3)))
typedef unsigned short bf16;
typedef short bf16x8 __attribute__((ext_vector_type(8)));
typedef float f32x4 __attribute__((ext_vector_type(4)));
typedef float f32x2 __attribute__((ext_vector_type(2)));
typedef unsigned u32x4 __attribute__((ext_vector_type(4)));
typedef unsigned u32x2 __attribute__((ext_vector_type(2)));

constexpr int T = 16384, D = 1024, GRIDW = 64, NROWS = 256;
constexpr int DC = 512, CONVK = 31, NHEAD = 8, HDIM = 64, DIN = 2560;
constexpr int NE = 32, DFF = 1024, TK = T * 4;
constexpr float EPS = 1e-5f;
constexpr float LOG2E = 1.4426950408889634f;

constexpr size_t MiB = 1u << 20;
constexpr size_t WS_CTL = 0, CTL_ZERO_BYTES = 65536;
constexpr size_t WS_WIN = 1 * MiB;
constexpr size_t WS_WOUT = 6 * MiB;
constexpr size_t WS_WGU = 8 * MiB;
constexpr size_t WS_WD = 72 * MiB;
constexpr size_t WS_H8 = 104 * MiB;
constexpr size_t WS_RS1 = 120 * MiB;
constexpr size_t WS_SSQ = WS_RS1 + 65536;
constexpr size_t WS_RS2 = WS_SSQ + 1 * MiB;
constexpr size_t WS_ERANK = WS_RS2 + 65536;
constexpr size_t WS_LIST = 122 * MiB;
constexpr size_t WS_GLIST = 124 * MiB;
constexpr size_t WS_OVL = 128 * MiB;
constexpr size_t WS_XB = WS_OVL;
constexpr size_t WS_U = WS_OVL + 32 * MiB;
constexpr size_t WS_Q = WS_OVL + 48 * MiB;
constexpr size_t WS_K = WS_OVL + 64 * MiB;
constexpr size_t WS_VT = WS_OVL + 80 * MiB;
constexpr size_t WS_MIX = WS_OVL + 96 * MiB;
constexpr size_t WS_HD = WS_OVL;
constexpr size_t WS_Y = 258 * MiB;
constexpr size_t WS_END = 386 * MiB;
static_assert(WS_HD + (size_t)(TK + 256) * DFF <= WS_Y && WS_MIX + (size_t)T * D * 2 <= WS_Y && WS_ERANK + (size_t)TK * 4 <= WS_LIST, "ws map");
constexpr float SA = 16.0f, SW = 1024.0f, SH = 4.0f;

constexpr int CW_TMO = 0, CW_BAR = 4096, CW_GCOUNT = 8192;

constexpr int RING_BYTES = 131072;
constexpr int AUX_OFF = RING_BYTES;
constexpr int MISC_OFF = AUX_OFF;
constexpr int AUX_TAB = AUX_OFF + 256;
constexpr int LDS_BYTES = 163840;
constexpr int MAXU = 9;
constexpr int MAXTILES = 288;
constexpr int AT_TOK = AUX_TAB;
constexpr int AT_ROWF = AT_TOK + MAXU * 1024;
constexpr int AT_TILE = AT_ROWF + MAXU * 1024;
constexpr int AT_OFFS = AT_TILE + MAXTILES * 4;
constexpr int AT_BIAS = AT_OFFS + 80 * 4;
constexpr int AT_END = AT_BIAS + MAXU * 1024;
static_assert(AT_END <= LDS_BYTES, "LDS aux map");

#define RLX_AGENT __ATOMIC_RELAXED, __HIP_MEMORY_SCOPE_AGENT
#define LDS_WAIT() asm volatile("s_waitcnt lgkmcnt(0)" ::: "memory")
#define VM_WAIT() asm volatile("s_waitcnt vmcnt(0)" ::: "memory")

__device__ __forceinline__ unsigned cvt_pk_bf16(float lo, float hi) { unsigned r; asm volatile("v_cvt_pk_bf16_f32 %0, %1, %2" : "=v"(r) : "v"(lo), "v"(hi)); return r; }
__device__ __forceinline__ float clamp8(float v) { return __builtin_fminf(__builtin_fmaxf(v, -448.0f), 448.0f); }
__device__ __forceinline__ unsigned pk4_fp8(float a, float b, float c, float d) { unsigned w = __builtin_amdgcn_cvt_pk_fp8_f32(clamp8(a), clamp8(b), 0u, false); return __builtin_amdgcn_cvt_pk_fp8_f32(clamp8(c), clamp8(d), w, true); }
__device__ __forceinline__ float bf_lo(unsigned w) { return __uint_as_float(w << 16); }
__device__ __forceinline__ float bf_hi(unsigned w) { return __uint_as_float(w & 0xffff0000u); }
__device__ __forceinline__ float fast_exp2(float x) { return __builtin_amdgcn_exp2f(x); }
__device__ __forceinline__ float fast_rcp(float x) { return __builtin_amdgcn_rcpf(x); }
__device__ __forceinline__ float sigmoidf_(float x) { return fast_rcp(1.0f + fast_exp2(-LOG2E * x)); }

namespace pg8 {
constexpr int BM = 256, BK = 64, HALF = 128, HTB = HALF * BK * 2, STAGE_BYTES = 8 * HTB, NXCD = 8, WGM = 8;
__host__ __device__ __forceinline__ int lds_byte(int r, int c) { const int st = (r >> 4) * 2 + (c >> 5), rr = r & 15, cc = c & 31, ob = rr * 64 + cc * 2; return st * 1024 + (ob ^ (((ob >> 9) & 1) << 5)); }
__host__ __device__ __forceinline__ void stage_rc(int b, int& R, int& C) { const int st = b / 1024, sb = b % 1024, swz = sb ^ (((sb >> 9) & 1) << 5); R = (st >> 1) * 16 + swz / 64; C = (st & 1) * 32 + (swz % 64) / 2; }
__host__ __device__ __forceinline__ int perm32(int rho) { const int n = rho >> 4, i = rho & 15; return 8 * (i >> 2) + 4 * n + (i & 3); }

typedef int i32x8 __attribute__((ext_vector_type(8))); typedef int i32x4v __attribute__((ext_vector_type(4)));
__device__ __forceinline__ i32x8 cat8(bf16x8 a, bf16x8 b) { return __builtin_shufflevector(__builtin_bit_cast(i32x4v, a), __builtin_bit_cast(i32x4v, b), 0, 1, 2, 3, 4, 5, 6, 7); }
struct Unit { const char* A; const char* B; int pm, pn, slot; };

struct StaticOrder {
    static constexpr bool GATHER = false;
    const char* A; const char* Bt; int KB  ; int nM, nN, nwg, G, c;
    __device__ void init(const void* A_, const void* Bt_, int M, int N, int KB_, int G_, int c_) { A = (const char*)A_; Bt = (const char*)Bt_; KB = KB_; nM = M / BM; nN = N / BM; nwg = nM * nN; G = G_; c = c_; }
    __device__ __forceinline__ bool next(int i, Unit& u) const {
        const long L = (long)i * G + c; if (L >= nwg) return false;
        int wgid = (int)L; { const int q = nwg / NXCD, r = nwg % NXCD, xcd = wgid % NXCD, off = wgid / NXCD; wgid = (xcd < r ? xcd * (q + 1) : r * (q + 1) + (xcd - r) * q) + off; }
        const int nig = WGM * nN, gid = wgid / nig, fm = gid * WGM, gsz = (nM - fm) < WGM ? (nM - fm) : WGM;
        u.pm = fm + ((wgid % nig) % gsz); u.pn = (wgid % nig) / gsz;
        u.A = A + (size_t)u.pm * BM * KB; u.B = Bt + (size_t)u.pn * BM * KB; u.slot = 0; return true;
    }
    __device__ __forceinline__ void voff(const Unit&, unsigned (&v)[2][2]) const {
#pragma unroll
        for (int i = 0; i < 2; ++i) { int R, C; stage_rc((int)threadIdx.x * 16 + i * 8192, R, C);
#pragma unroll
            for (int h = 0; h < 2; ++h) v[h][i] = (unsigned)((R + HALF * h) * KB + C * 2); }
    }
};

template <bool GATHER_> struct GroupedOrder {
    static constexpr bool GATHER = GATHER_;
    const char* A; const char* Bt; int KB  ; int ntn, Nexp  , G, c, ntiles;
    const LAS int* tile; const LAS int* offs; const LAS unsigned* tokoff;
    __device__ __forceinline__ bool next(int i, Unit& u) const {
        const int L = i * G + c; if (L >= ntiles * ntn) return false;
        const int mt = L / ntn; u.pn = L - mt * ntn; const int te = tile[mt], e = te >> 16, j = te & 0xffff;
        u.pm = mt; u.slot = i;
        u.A = GATHER ? A : A + (size_t)(offs[e] + 256 * j) * KB;
        u.B = Bt + ((size_t)e * Nexp + (size_t)u.pn * BM) * KB; return true;
    }
    __device__ __forceinline__ void voff(const Unit& u, unsigned (&v)[2][2]) const {
#pragma unroll
        for (int i = 0; i < 2; ++i) { int R, C; stage_rc((int)threadIdx.x * 16 + i * 8192, R, C);
#pragma unroll
            for (int h = 0; h < 2; ++h) v[h][i] = GATHER ? tokoff[u.slot * 256 + R + HALF * h] + (unsigned)C * 2u : (unsigned)((R + HALF * h) * KB + C * 2); }
    }
    __device__ __forceinline__ void meta(const Unit& u, int& e, int& row0, int& nvalid) const { const int te = tile[u.pm]; e = te >> 16; const int j = te & 0xffff; row0 = offs[e] + 256 * j; const int rem = offs[33 + e] - 256 * j; nvalid = rem < 256 ? rem : 256; }
};

template <class Epi, class Sched, bool FP8 = false, bool ALIGN_EPI = true>
__device__ __forceinline__ void gemm_phase(LAS unsigned char* lds, const int KB, const Sched& S, const Epi& E) {
    const int tid = threadIdx.x, wid = __builtin_amdgcn_readfirstlane(tid >> 6), lane = tid & 63, wr = wid >> 2, wc = wid & 3, fr = lane & 15, fq = lane >> 4;
    const int nt = KB / (BK * 2);
    unsigned voffB[2];
#pragma unroll
    for (int i = 0; i < 2; ++i) { int R, C; stage_rc(tid * 16 + i * 8192, R, C); const int Rb = (R & ~31) + perm32(R & 31); voffB[i] = (unsigned)(Rb * KB + C * 2); }
    const size_t kstep = (size_t)(BK * 2);
    const size_t hstep = (size_t)HALF * KB;
    const unsigned ldsw = (unsigned)wid * 1024u;
    const int aoff = lds_byte(wr * 64 + fr, fq * 8), boff = lds_byte(wc * 32 + fr, fq * 8);
#define PG8_SA(b, h) (((b) * 2 + (h)) * HTB)
#define PG8_SB(b, h) ((4 + (b) * 2 + (h)) * HTB)
#define PG8_STAGE2(bufoff, gbase, v0, v1) do { \
        __builtin_amdgcn_global_load_lds((const unsigned*)((const char*)(gbase) + (v0)), (LAS unsigned*)(lds + (bufoff) + ldsw), 16, 0, 0); \
        __builtin_amdgcn_global_load_lds((const unsigned*)((const char*)(gbase) + (v1)), (LAS unsigned*)(lds + (bufoff) + ldsw + 8192), 16, 0, 0); } while (0)
#define PG8_STAGEB(bufoff, gbase) PG8_STAGE2(bufoff, gbase, voffB[0], voffB[1])
#define PG8_LDA(dst, b, h) do { _Pragma("unroll") for (int m = 0; m < 4; ++m) _Pragma("unroll") for (int k = 0; k < 2; ++k) dst[m][k] = *(const LAS bf16x8*)(lds + PG8_SA(b, h) + aoff + m * 2048 + k * 1024); } while (0)
#define PG8_LDB(dst, b, h) do { _Pragma("unroll") for (int n = 0; n < 2; ++n) _Pragma("unroll") for (int k = 0; k < 2; ++k) dst[n][k] = *(const LAS bf16x8*)(lds + PG8_SB(b, h) + boff + n * 2048 + k * 1024); } while (0)
#define PG8_MMA(ai, bj, At, Bt) do { __builtin_amdgcn_s_setprio(1); _Pragma("unroll") for (int m = 0; m < 4; ++m) _Pragma("unroll") for (int n = 0; n < 2; ++n) { \
        if constexpr (FP8) { const i32x8 b8_ = cat8(Bt[n][0], Bt[n][1]), a8_ = cat8(At[m][0], At[m][1]); \
            asm volatile("v_mfma_scale_f32_16x16x128_f8f6f4 %0, %1, %2, %0, %3, %3 op_sel_hi:[0,0,0]" : "+v"(acc[ai][bj][m][n]) : "v"(b8_), "v"(a8_), "v"(scl)); } \
        else { _Pragma("unroll") for (int k = 0; k < 2; ++k) acc[ai][bj][m][n] = __builtin_amdgcn_mfma_f32_16x16x32_bf16(Bt[n][k], At[m][k], acc[ai][bj][m][n], 0, 0, 0); } } \
        __builtin_amdgcn_s_setprio(0); } while (0)
#define PG8_WAIT_V(n) asm volatile("s_waitcnt vmcnt(" #n ")" ::: "memory")
#define PG8_WAIT_L(n) asm volatile("s_waitcnt lgkmcnt(" #n ")" ::: "memory")
#define PG8_BAR __builtin_amdgcn_s_barrier()
#define PG8_SCHED __builtin_amdgcn_sched_barrier(0)
    Unit cur, nxt; int ui = 0;
    if (!S.next(0, cur)) return;
    unsigned scl = 0x7f7f7f7fu; asm volatile("" : "+v"(scl));
    unsigned vAc[2][2];
    S.voff(cur, vAc);
    f32x4 acc[2][2][4][2];
#pragma unroll
    for (int a = 0; a < 2; ++a)
#pragma unroll
        for (int b = 0; b < 2; ++b)
#pragma unroll
            for (int m = 0; m < 4; ++m)
#pragma unroll
                for (int n = 0; n < 2; ++n) acc[a][b][m][n] = (f32x4){0.f, 0.f, 0.f, 0.f};
    bf16x8 At[4][2], B0[2][2], B1[2][2];
    const char* cA = cur.A; const char* cB = cur.B;
    PG8_STAGEB(PG8_SB(0, 0), cB); PG8_STAGEB(PG8_SB(0, 1), cB + hstep); PG8_STAGE2(PG8_SA(0, 0), cA, vAc[0][0], vAc[0][1]); PG8_STAGE2(PG8_SA(0, 1), cA, vAc[1][0], vAc[1][1]);
    if (wr == 1) PG8_BAR;
    PG8_WAIT_V(2); PG8_BAR;
    PG8_STAGEB(PG8_SB(1, 0), cB + kstep); PG8_STAGE2(PG8_SA(1, 0), cA + kstep, vAc[0][0], vAc[0][1]); PG8_STAGEB(PG8_SB(1, 1), cB + hstep + kstep);
    PG8_WAIT_V(6); PG8_BAR;
    for (;;) {
        const bool has_next = S.next(ui + 1, nxt);
        const char* nA = has_next ? nxt.A : cA; const char* nB = has_next ? nxt.B : cB;
#pragma unroll 1
        for (int t = 0; t < nt; t += 2) {
            const bool last = (t == nt - 2);
            const char* a1 = cA + (size_t)(t + 1) * kstep;
            const char* a2 = last ? nA : cA + (size_t)(t + 2) * kstep; const char* b2 = last ? nB : cB + (size_t)(t + 2) * kstep;
            const char* a3 = a2 + kstep; const char* b3 = b2 + kstep;
            unsigned w00 = vAc[0][0], w01 = vAc[0][1], w10 = vAc[1][0], w11 = vAc[1][1];
            if constexpr (Sched::GATHER) { if (last && has_next) { unsigned vn[2][2]; S.voff(nxt, vn); w00 = vn[0][0]; w01 = vn[0][1]; w10 = vn[1][0]; w11 = vn[1][1]; } }
            PG8_LDB(B0, 0, 0); PG8_LDB(B1, 0, 1); PG8_SCHED; PG8_LDA(At, 0, 0); PG8_STAGE2(PG8_SA(1, 1), a1, vAc[1][0], vAc[1][1]);
            PG8_WAIT_V(8); PG8_WAIT_L(0); PG8_BAR; PG8_MMA(0, 0, At, B0); PG8_MMA(0, 1, At, B1); PG8_BAR; PG8_SCHED;
            PG8_LDA(At, 0, 1); PG8_STAGEB(PG8_SB(0, 0), b2); PG8_STAGEB(PG8_SB(0, 1), b2 + hstep); PG8_STAGE2(PG8_SA(0, 0), a2, w00, w01);
            PG8_WAIT_V(8); PG8_WAIT_L(0); PG8_BAR; PG8_MMA(1, 0, At, B0); PG8_MMA(1, 1, At, B1); PG8_BAR; PG8_SCHED;
            PG8_LDB(B0, 1, 0); PG8_LDB(B1, 1, 1); PG8_SCHED; PG8_LDA(At, 1, 0); PG8_STAGE2(PG8_SA(0, 1), a2, w10, w11);
            PG8_WAIT_V(8); PG8_WAIT_L(0); PG8_BAR; PG8_MMA(0, 0, At, B0); PG8_MMA(0, 1, At, B1); PG8_BAR; PG8_SCHED;
            PG8_LDA(At, 1, 1); PG8_STAGEB(PG8_SB(1, 0), b3); PG8_STAGEB(PG8_SB(1, 1), b3 + hstep); PG8_STAGE2(PG8_SA(1, 0), a3, w00, w01);
            PG8_WAIT_V(8); PG8_WAIT_L(0); PG8_BAR; PG8_MMA(1, 0, At, B0); PG8_MMA(1, 1, At, B1); PG8_BAR; PG8_SCHED;
        }
        if constexpr (ALIGN_EPI) { if (wr == 0) PG8_BAR; }
        if constexpr (FP8) asm volatile("s_nop 15\n\ts_nop 15" ::: "memory");
        { int fr_ = fr, fq_ = fq; asm volatile("" : "+v"(fr_), "+v"(fq_));
          E(acc, cur, wr, wc, fr_, fq_); }
        if (!has_next) break;
#pragma unroll
        for (int a = 0; a < 2; ++a)
#pragma unroll
            for (int b = 0; b < 2; ++b)
#pragma unroll
                for (int m = 0; m < 4; ++m)
#pragma unroll
                    for (int n = 0; n < 2; ++n) acc[a][b][m][n] = (f32x4){0.f, 0.f, 0.f, 0.f};
        cur = nxt; cA = nA; cB = nB; ++ui;
        if constexpr (Sched::GATHER) S.voff(cur, vAc);
        if constexpr (ALIGN_EPI) { if (wr == 1) PG8_BAR; }
    }
    PG8_WAIT_V(0);
    if constexpr (!ALIGN_EPI) { if (wr == 0) PG8_BAR; }
    PG8_BAR;
#undef PG8_SA
#undef PG8_SB
#undef PG8_STAGE2
#undef PG8_STAGEB
#undef PG8_LDA
#undef PG8_LDB
#undef PG8_MMA
#undef PG8_WAIT_V
#undef PG8_WAIT_L
#undef PG8_BAR
#undef PG8_SCHED
}
}

#define XB_TMO      128
#define XB_XCNT(j)  (256  + 64 * (j))
#define XB_XSUB(j)  (1280 + 64 * (j))
#define XB_XGEN(j)  (2304 + 64 * (j))
#define XB_TOP      3328
#define XB_TOPGEN   3392
#define XCD_BAR_WORDS 3456
#define XB_SPIN_CAP (1u << 18)

__device__ __forceinline__ unsigned xb_ld(unsigned* p)              { return __hip_atomic_load(p, __ATOMIC_RELAXED, __HIP_MEMORY_SCOPE_AGENT); }
__device__ __forceinline__ unsigned xb_add(unsigned* p, unsigned v) { return __hip_atomic_fetch_add(p, v, __ATOMIC_RELAXED, __HIP_MEMORY_SCOPE_AGENT); }
__device__ __forceinline__ unsigned xb_xcc_id() { return (unsigned)__builtin_amdgcn_s_getreg((3 << 11) | 20) & 0xFu; }
#define XB_SPIN(cond, bar) do { unsigned _sp = 0; while (cond) { __builtin_amdgcn_s_sleep(1); \
    if ((++_sp & 255u) == 0u) { if (xb_ld(&(bar)[XB_TMO])) break; if (_sp > XB_SPIN_CAP) { atomicAdd(&(bar)[XB_TMO], 1u); break; } } } } while (0)

struct XcdBarrier { unsigned* bar; unsigned x; volatile LAS unsigned* st; };

__device__ __forceinline__ XcdBarrier xcd_barrier_post(unsigned* bar, volatile LAS unsigned* st) {
    XcdBarrier b; b.bar = bar; b.x = xb_xcc_id(); b.st = st;
    if (threadIdx.x == 0) (void)xb_add(&bar[XB_XCNT(b.x)], 1u);
    return b;
}
__device__ __forceinline__ void xcd_barrier_complete(unsigned* bar, unsigned x, unsigned& nloc, unsigned& nx) {
    const unsigned G = gridDim.x * gridDim.y * gridDim.z;
    unsigned sum, cnt, mine, sp = 0u;
    for (;;) {
        sum = 0u; cnt = 0u; mine = 0u;
#pragma unroll
        for (unsigned j = 0; j < 16; ++j) { const unsigned c = xb_ld(&bar[XB_XCNT(j)]); sum += c; cnt += (c > 0u) ? 1u : 0u; mine = (j == x) ? c : mine; }
        if (sum == G) break;
        __builtin_amdgcn_s_sleep(1);
        if ((++sp & 255u) == 0u) { if (xb_ld(&bar[XB_TMO])) break; if (sp > XB_SPIN_CAP) { atomicAdd(&bar[XB_TMO], 1u); break; } }
    }
    nloc = mine > 0u ? mine : 1u; nx = cnt > 0u ? cnt : 1u;
}
__device__ __forceinline__ void xcd_barrier(const XcdBarrier& b) {
    asm volatile("s_waitcnt vmcnt(0)" ::: "memory");
    __syncthreads();
    if (threadIdx.x == 0) {
        unsigned* bar = b.bar;
        __builtin_amdgcn_s_waitcnt(0);
        unsigned nloc = b.st[0], nx = b.st[1];
        if (nloc == 0u) { xcd_barrier_complete(bar, b.x, nloc, nx); b.st[0] = nloc; b.st[1] = nx; }
        const unsigned old = xb_add(&bar[XB_XSUB(b.x)], 1u);
        const unsigned gen = old / nloc;
        if (old + 1u == (gen + 1u) * nloc) {
            __builtin_amdgcn_fence(__ATOMIC_RELEASE, "agent");
            asm volatile("s_waitcnt vmcnt(0)" ::: "memory");
            const unsigned og = xb_add(&bar[XB_TOP], 1u);
            const unsigned tg = og / nx;
            if (og + 1u == (tg + 1u) * nx) xb_add(&bar[XB_TOPGEN], 1u);
            else XB_SPIN(xb_ld(&bar[XB_TOPGEN]) == tg, bar);
            __builtin_amdgcn_fence(__ATOMIC_ACQUIRE, "agent");
            xb_add(&bar[XB_XGEN(b.x)], 1u);
            asm volatile("s_waitcnt vmcnt(0)" ::: "memory");
        } else {
            XB_SPIN(xb_ld(&bar[XB_XGEN(b.x)]) == gen, bar);
            __builtin_amdgcn_fence(__ATOMIC_ACQUIRE, "agent");
            asm volatile("s_waitcnt vmcnt(0)" ::: "memory");
        }
    }
    __syncthreads();
}

struct Frame {
    LAS unsigned char* lds;
    int tid, lane, wave, vcu, G;
    float* out; unsigned char* ws;
};

__device__ __forceinline__ float wave_sum(float v) {
#pragma unroll
    for (int o = 1; o < 64; o <<= 1) v += __shfl_xor(v, o);
    return v;
}

__device__ __forceinline__ void cvt_load(const float* W, int Nsrc, int k0, int n0, int wave, int lane, f32x4 (&v)[8]) {
#pragma unroll
    for (int rr = 0; rr < 8; ++rr) v[rr] = *(const GAS f32x4*)(W + (size_t)(k0 + wave * 8 + rr) * Nsrc + n0 + 4 * lane);
}
template <class DMap>
__device__ __forceinline__ void cvt_store(Frame& F, const f32x4 (&v)[8], const float* gain, int k0, int n0, bf16* WT, const DMap& dmap) {
    LAS float* scr = (LAS float*)F.lds;
    const int wave = F.wave, lane = F.lane;
#pragma unroll
    for (int rr = 0; rr < 8; ++rr) { const int k = wave * 8 + rr; *(LAS f32x4*)(scr + k * 256 + ((lane ^ wave) & 63) * 4) = v[rr]; }
    __syncthreads();
    const int kg = lane & 7, nl = lane >> 3;
    f32x4 g0 = (f32x4){1.f, 1.f, 1.f, 1.f}, g1 = g0;
    if (gain) { g0 = *(const GAS f32x4*)(gain + k0 + 8 * kg); g1 = *(const GAS f32x4*)(gain + k0 + 8 * kg + 4); }
#pragma unroll
    for (int s = 0; s < 4; ++s) {
        const int n = (s * 8 + wave) * 8 + nl, quad = n >> 2, c = n & 3;
        float e[8];
#pragma unroll
        for (int kk = 0; kk < 8; ++kk) e[kk] = scr[(8 * kg + kk) * 256 + ((quad ^ kg) * 4) + c];
        u32x4 o; o.x = cvt_pk_bf16(e[0] * g0[0], e[1] * g0[1]); o.y = cvt_pk_bf16(e[2] * g0[2], e[3] * g0[3]); o.z = cvt_pk_bf16(e[4] * g1[0], e[5] * g1[1]); o.w = cvt_pk_bf16(e[6] * g1[2], e[7] * g1[3]);
        *(GAS u32x4*)(WT + (size_t)dmap(n0 + n) * 1024 + k0 + 8 * kg) = o;
    }
    __syncthreads();
}
struct MapIdent { int base; __device__ __forceinline__ int operator()(int n) const { return base + n; } };
struct MapInProj { __device__ __forceinline__ int operator()(int n) const { if (n >= 1024) return n; const int s = n >> 9, c = n & 511; return 256 * (c >> 7) + 128 * s + (c & 127); } };
__device__ __forceinline__ void cvt8_load(const float* W, int k0, int n0, int wave, int lane, f32x4 (&v)[8]) {
#pragma unroll
    for (int rr = 0; rr < 8; ++rr) v[rr] = *(const GAS f32x4*)(W + (size_t)(k0 + wave * 16 + 2 * rr + (lane >> 5)) * 1024 + n0 + 4 * (lane & 31));
}
__device__ __forceinline__ void cvt8_store(Frame& F, const f32x4 (&v)[8], const float* gain, int k0, unsigned char* WT  ) {
    LAS float* scr = (LAS float*)F.lds;
    const int wave = F.wave, lane = F.lane;
#pragma unroll
    for (int rr = 0; rr < 8; ++rr) { const int k = wave * 16 + 2 * rr + (lane >> 5); *(LAS f32x4*)(scr + k * 128 + (((lane & 31) ^ (wave & 7)) * 4)) = v[rr]; }
    __syncthreads();
    const int kg = lane & 7, nl = lane >> 3;
    f32x4 g[4];
#pragma unroll
    for (int i = 0; i < 4; ++i) g[i] = gain ? *(const GAS f32x4*)(gain + k0 + 16 * kg + 4 * i) * SW : (f32x4){SW, SW, SW, SW};
#pragma unroll
    for (int s = 0; s < 2; ++s) {
        const int n = (s * 8 + wave) * 8 + nl, quad = n >> 2, c = n & 3;
        float e[16];
#pragma unroll
        for (int kk = 0; kk < 16; ++kk) e[kk] = scr[(16 * kg + kk) * 128 + ((quad ^ kg) * 4) + c];
        u32x4 o; o.x = pk4_fp8(e[0] * g[0][0], e[1] * g[0][1], e[2] * g[0][2], e[3] * g[0][3]); o.y = pk4_fp8(e[4] * g[1][0], e[5] * g[1][1], e[6] * g[1][2], e[7] * g[1][3]);
        o.z = pk4_fp8(e[8] * g[2][0], e[9] * g[2][1], e[10] * g[2][2], e[11] * g[2][3]); o.w = pk4_fp8(e[12] * g[3][0], e[13] * g[3][1], e[14] * g[3][2], e[15] * g[3][3]);
        *(GAS u32x4*)(WT + (size_t)n * 1024 + k0 + 16 * kg) = o;
    }
    __syncthreads();
}

constexpr int N_CVT_ITEMS = 96 * 64 + 160 + 64;
struct P0Ptrs { const float *x, *g_mix, *w_in, *w_out, *g_ffn, *w_gate, *w_up, *w_down; };
__device__ __forceinline__ void cvt_item_src(const P0Ptrs& P, int it, const float*& W, int& Nsrc, int& k0, int& n0) {
    if (it < 6144) { const int mat = it >> 6, rem = it & 63, which = mat >> 5, e = mat & 31; const float* wg_ = P.w_gate; const float* wu_ = P.w_up; const float* wd_ = P.w_down; const float* base = wg_; if (which == 1) base = wu_; if (which == 2) base = wd_;
        W = base + (size_t)e * 1024 * 1024; Nsrc = 1024; k0 = (rem >> 3) * 128; n0 = (rem & 7) * 128; }
    else if (it < 6304) { const int r = it - 6144; W = P.w_in; Nsrc = DIN; k0 = (r / 10) * 64; n0 = (r % 10) * 256; }
    else { const int r = it - 6304; W = P.w_out; Nsrc = 1024; k0 = (r >> 2) * 64; n0 = (r & 3) * 256; }
}
__device__ __forceinline__ void cvt_item_store(Frame& F, const P0Ptrs& P, int it, const f32x4 (&v)[8]) {
    if (it < 6144) { const int mat = it >> 6, rem = it & 63, which = mat >> 5, e = mat & 31; const int k0 = (rem >> 3) * 128, nt = rem & 7;
        if (which == 2) cvt8_store(F, v, nullptr, k0, F.ws + WS_WD + ((size_t)e * 1024 + 128 * nt) * 1024);
        else cvt8_store(F, v, P.g_ffn, k0, F.ws + WS_WGU + ((size_t)e * 2048 + 256 * nt + 128 * which) * 1024); }
    else if (it < 6304) { const int r = it - 6144; cvt_store(F, v, P.g_mix, (r / 10) * 64, (r % 10) * 256, (bf16*)(F.ws + WS_WIN), MapInProj{}); }
    else { const int r = it - 6304; cvt_store(F, v, nullptr, (r >> 2) * 64, (r & 3) * 256, (bf16*)(F.ws + WS_WOUT), MapIdent{0}); }
}
__device__ __forceinline__ void p0_prologue(Frame& F, const P0Ptrs& P) {
    { const int gw = F.vcu * 8 + F.wave, NGW = F.G * 8; bf16* XB = (bf16*)(F.ws + WS_XB); float* rs1 = (float*)(F.ws + WS_RS1);
      for (int m = gw; m < T; m += NGW) {
        const GAS f32x4* xr = (const GAS f32x4*)(P.x + (size_t)m * D) + F.lane; f32x4 v[4]; float s = 0.f;
#pragma unroll
        for (int j = 0; j < 4; ++j) { v[j] = xr[64 * j]; s += (v[j].x * v[j].x + v[j].y * v[j].y) + (v[j].z * v[j].z + v[j].w * v[j].w); }
        s = wave_sum(s);
        if (F.lane == 0) rs1[m] = 1.0f / sqrtf(s * (1.0f / D) + EPS);
        GAS u32x2* o8 = (GAS u32x2*)(XB + (size_t)m * D) + F.lane;
#pragma unroll
        for (int j = 0; j < 4; ++j) { u32x2 w; w.x = cvt_pk_bf16(v[j].x, v[j].y); w.y = cvt_pk_bf16(v[j].z, v[j].w); o8[64 * j] = w; }
      } }
    int it = F.vcu; if (it >= N_CVT_ITEMS) return;
    f32x4 cur[8], nxt[8];
    { const float* W; int Nsrc, k0, n0; cvt_item_src(P, it, W, Nsrc, k0, n0); if (it < 6144) cvt8_load(W, k0, n0, F.wave, F.lane, cur); else cvt_load(W, Nsrc, k0, n0, F.wave, F.lane, cur); }
    for (;;) {
        int itn = it + F.G; bool more = itn < N_CVT_ITEMS;
        if (more) { const float* W; int Nsrc, k0, n0; cvt_item_src(P, itn, W, Nsrc, k0, n0); if (itn < 6144) cvt8_load(W, k0, n0, F.wave, F.lane, nxt); else cvt_load(W, Nsrc, k0, n0, F.wave, F.lane, nxt); }
        cvt_item_store(F, P, it, cur);
        if (!more) break;
        it = itn; itn = it + F.G; more = itn < N_CVT_ITEMS;
        if (more) { const float* W; int Nsrc, k0, n0; cvt_item_src(P, itn, W, Nsrc, k0, n0); if (itn < 6144) cvt8_load(W, k0, n0, F.wave, F.lane, cur); else cvt_load(W, Nsrc, k0, n0, F.wave, F.lane, cur); }
        cvt_item_store(F, P, it, nxt);
        if (!more) break;
        it = itn;
    }
}

typedef const f32x4 (&AccRef)[2][2][4][2];
struct EpiInProj {
    const float* rs1; const float* b_in; bf16* U; bf16* Q; bf16* Kk;
    __device__ __forceinline__ void operator()(AccRef acc, const pg8::Unit& u, int wr, int wc, int fr, int fq) const {
        const int row0 = u.pm * 256 + wr * 64 + fr, cl = wc * 32 + 8 * fq;
        if (u.pn < 4) {
            const int ch = 128 * u.pn + cl;
            f32x4 ba[2], bg[2];
#pragma unroll
            for (int n = 0; n < 2; ++n) { ba[n] = *(const GAS f32x4*)(b_in + ch + 4 * n); bg[n] = *(const GAS f32x4*)(b_in + 512 + ch + 4 * n); }
#pragma unroll
            for (int ai = 0; ai < 2; ++ai)
#pragma unroll
                for (int m = 0; m < 4; ++m) { const int row = row0 + ai * 128 + m * 16; const float rs = rs1[row];
                    float o[8];
#pragma unroll
                    for (int n = 0; n < 2; ++n)
#pragma unroll
                        for (int j = 0; j < 4; ++j) { const float a = acc[ai][0][m][n][j] * rs + ba[n][j], g = acc[ai][1][m][n][j] * rs + bg[n][j]; o[4 * n + j] = a * sigmoidf_(g); }
                    u32x4 w; w.x = cvt_pk_bf16(o[0], o[1]); w.y = cvt_pk_bf16(o[2], o[3]); w.z = cvt_pk_bf16(o[4], o[5]); w.w = cvt_pk_bf16(o[6], o[7]);
                    *(GAS u32x4*)(U + (size_t)row * 512 + ch) = w; }
        } else {
            const int t = (u.pn - 4) >> 1; bf16* O = t == 0 ? Q : Kk; const int colt = ((u.pn - 4) & 1) * 256 + cl; const float* bias = b_in + 1024 + 512 * t + colt;
            f32x4 bv[2][2];
#pragma unroll
            for (int bj = 0; bj < 2; ++bj)
#pragma unroll
                for (int n = 0; n < 2; ++n) bv[bj][n] = *(const GAS f32x4*)(bias + bj * 128 + 4 * n);
#pragma unroll
            for (int ai = 0; ai < 2; ++ai)
#pragma unroll
                for (int m = 0; m < 4; ++m) { const int row = row0 + ai * 128 + m * 16; const float rs = rs1[row];
#pragma unroll
                    for (int bj = 0; bj < 2; ++bj) { const f32x4 v0 = acc[ai][bj][m][0] * rs + bv[bj][0], v1 = acc[ai][bj][m][1] * rs + bv[bj][1];
                        u32x4 w; w.x = cvt_pk_bf16(v0[0], v0[1]); w.y = cvt_pk_bf16(v0[2], v0[3]); w.z = cvt_pk_bf16(v1[0], v1[1]); w.w = cvt_pk_bf16(v1[2], v1[3]);
                        *(GAS u32x4*)(O + (size_t)row * 512 + colt + bj * 128) = w; } }
        }
    }
};
struct EpiVt {
    const float* rs1; const float* b_v; bf16* Vt;
    __device__ __forceinline__ void operator()(AccRef acc, const pg8::Unit& u, int wr, int wc, int fr, int fq) const {
        const int c0 = u.pm * 256 + wr * 64 + fr, t0 = u.pn * 256 + wc * 32 + 8 * fq;
        f32x4 rv[2][2];
#pragma unroll
        for (int bj = 0; bj < 2; ++bj)
#pragma unroll
            for (int n = 0; n < 2; ++n) rv[bj][n] = *(const GAS f32x4*)(rs1 + t0 + bj * 128 + 4 * n);
#pragma unroll
        for (int ai = 0; ai < 2; ++ai)
#pragma unroll
            for (int m = 0; m < 4; ++m) { const int c = c0 + ai * 128 + m * 16; const float bb = b_v[c];
#pragma unroll
                for (int bj = 0; bj < 2; ++bj) { const int t = t0 + bj * 128; const f32x4 v0 = acc[ai][bj][m][0] * rv[bj][0] + bb, v1 = acc[ai][bj][m][1] * rv[bj][1] + bb;
                    u32x4 w; w.x = cvt_pk_bf16(v0[0], v0[1]); w.y = cvt_pk_bf16(v0[2], v0[3]); w.z = cvt_pk_bf16(v1[0], v1[1]); w.w = cvt_pk_bf16(v1[2], v1[3]);
                    *(GAS u32x4*)(Vt + ((size_t)((t >> 6) * 8 + (c >> 6)) * 64 + (c & 63)) * 64 + (t & 63)) = w; } }
    }
};
struct EpiOut {
    const float* x; const float* b_out; float* h; unsigned char* h8; float* ssq;
    __device__ __forceinline__ void operator()(AccRef acc, const pg8::Unit& u, int wr, int wc, int fr, int fq) const {
        const int row0 = u.pm * 256 + wr * 64 + fr, col0 = u.pn * 256 + wc * 32 + 8 * fq;
        f32x4 bv[2][2];
#pragma unroll
        for (int bj = 0; bj < 2; ++bj)
#pragma unroll
            for (int n = 0; n < 2; ++n) bv[bj][n] = *(const GAS f32x4*)(b_out + col0 + bj * 128 + 4 * n);
#pragma unroll
        for (int ai = 0; ai < 2; ++ai)
#pragma unroll
            for (int m = 0; m < 4; ++m) { const int row = row0 + ai * 128 + m * 16; const size_t off = (size_t)row * D + col0; float s = 0.f;
#pragma unroll
                for (int bj = 0; bj < 2; ++bj) {
                    const f32x4 x0 = *(const GAS f32x4*)(x + off + bj * 128), x1 = *(const GAS f32x4*)(x + off + bj * 128 + 4);
                    const f32x4 v0 = acc[ai][bj][m][0] + bv[bj][0] + x0, v1 = acc[ai][bj][m][1] + bv[bj][1] + x1;
                    s += (v0[0] * v0[0] + v0[1] * v0[1]) + (v0[2] * v0[2] + v0[3] * v0[3]) + (v1[0] * v1[0] + v1[1] * v1[1]) + (v1[2] * v1[2] + v1[3] * v1[3]);
                    *(GAS f32x4*)(h + off + bj * 128) = v0; *(GAS f32x4*)(h + off + bj * 128 + 4) = v1;
                    u32x2 w; w.x = pk4_fp8(v0[0] * SA, v0[1] * SA, v0[2] * SA, v0[3] * SA); w.y = pk4_fp8(v1[0] * SA, v1[1] * SA, v1[2] * SA, v1[3] * SA);
                    *(GAS u32x2*)(h8 + off + bj * 128) = w; }
                s += __shfl_xor(s, 16); s += __shfl_xor(s, 32);
                if (fq == 0) ssq[(size_t)row * 16 + u.pn * 4 + wc] = s; }
    }
};
struct EpiGU {
    const pg8::GroupedOrder<true>* S; const LAS float* rowf; const LAS float* biasL; unsigned char* HD;
    __device__ __forceinline__ void operator()(AccRef acc, const pg8::Unit& u, int wr, int wc, int fr, int fq) const {
        int ue, urow0, unvalid; S->meta(u, ue, urow0, unvalid);
        const int rl0 = wr * 64 + fr, ch = 128 * u.pn + wc * 32 + 8 * fq;
        f32x4 bg[2], bu[2];
#pragma unroll
        for (int n = 0; n < 2; ++n) { bg[n] = *(const LAS f32x4*)(biasL + u.slot * 256 + wc * 32 + 8 * fq + 4 * n); bu[n] = *(const LAS f32x4*)(biasL + u.slot * 256 + 128 + wc * 32 + 8 * fq + 4 * n); }
#pragma unroll
        for (int ai = 0; ai < 2; ++ai)
#pragma unroll
            for (int m = 0; m < 4; ++m) { const int rl = rl0 + ai * 128 + m * 16; const float rs = rowf[u.slot * 256 + rl];
                float o[8];
#pragma unroll
                for (int n = 0; n < 2; ++n)
#pragma unroll
                    for (int j = 0; j < 4; ++j) { float gt = acc[ai][0][m][n][j] * rs + bg[n][j], up = acc[ai][1][m][n][j] * rs + bu[n][j];
                        gt = fminf(gt, 7.0f); up = fminf(fmaxf(up, -7.0f), 7.0f);
                        o[4 * n + j] = (up + 1.0f) * gt * fast_rcp(1.0f + fast_exp2(-1.702f * LOG2E * gt)); }
                if (rl < unvalid) { u32x2 w; w.x = pk4_fp8(o[0] * SH, o[1] * SH, o[2] * SH, o[3] * SH); w.y = pk4_fp8(o[4] * SH, o[5] * SH, o[6] * SH, o[7] * SH);
                    *(GAS u32x2*)(HD + (size_t)(urow0 + rl) * DFF + ch) = w; } }
    }
};
struct EpiDown {
    const pg8::GroupedOrder<false>* S; const LAS float* rowf; const LAS float* biasL; bf16* Y;
    __device__ __forceinline__ void operator()(AccRef acc, const pg8::Unit& u, int wr, int wc, int fr, int fq) const {
        int ue, urow0, unvalid; S->meta(u, ue, urow0, unvalid);
        const int rl0 = wr * 64 + fr, col0 = u.pn * 256 + wc * 32 + 8 * fq;
        f32x4 bv[2][2];
#pragma unroll
        for (int bj = 0; bj < 2; ++bj)
#pragma unroll
            for (int n = 0; n < 2; ++n) bv[bj][n] = *(const LAS f32x4*)(biasL + u.slot * 256 + wc * 32 + 8 * fq + bj * 128 + 4 * n);
#pragma unroll
        for (int ai = 0; ai < 2; ++ai)
#pragma unroll
            for (int m = 0; m < 4; ++m) { const int rl = rl0 + ai * 128 + m * 16; const float gt = rowf[u.slot * 256 + rl];
                if (rl < unvalid) {
#pragma unroll
                    for (int bj = 0; bj < 2; ++bj) { const f32x4 v0 = (acc[ai][bj][m][0] * (1.0f / (SH * SW)) + bv[bj][0]) * gt, v1 = (acc[ai][bj][m][1] * (1.0f / (SH * SW)) + bv[bj][1]) * gt;
                        u32x4 w; w.x = cvt_pk_bf16(v0[0], v0[1]); w.y = cvt_pk_bf16(v0[2], v0[3]); w.z = cvt_pk_bf16(v1[0], v1[1]); w.w = cvt_pk_bf16(v1[2], v1[3]);
                        *(GAS u32x4*)(Y + (size_t)(urow0 + rl) * D + col0 + bj * 128) = w; } } }
    }
};

constexpr int CV_T = 32, CV_ROWS = CV_T + 30;
constexpr int CV_IN = 0, CV_OUT = 65536;
__device__ __forceinline__ void conv_unit(Frame& F, const float* ln_g, const float* ln_b, int t0, const float (&w0)[31], const float (&w1)[31], float cb0, float cb1) {
    const bf16* U = (const bf16*)(F.ws + WS_U); bf16* MIX = (bf16*)(F.ws + WS_MIX);
    LAS unsigned char* lin = F.lds + CV_IN; LAS float* lout = (LAS float*)(F.lds + CV_OUT);
    for (int p = F.tid; p < CV_ROWS * 64; p += 512) { const int r = p >> 6, c = p & 63; const int t = t0 - 15 + r;
        u32x4 v = (u32x4){0u, 0u, 0u, 0u}; if (t >= 0 && t < T) v = *(const GAS u32x4*)(U + (size_t)t * 512 + c * 8);
        *(LAS u32x4*)(lin + r * 1024 + c * 16) = v; }
    __syncthreads();
    { const int p = F.tid & 255, q = F.tid >> 8;
      float o0[16], o1[16];
#pragma unroll
      for (int i = 0; i < 16; ++i) { o0[i] = cb0; o1[i] = cb1; }
#pragma unroll
      for (int r = 0; r < 46; ++r) { const unsigned wv = *(const LAS unsigned*)(lin + (16 * q + r) * 1024 + p * 4); const float x0 = bf_lo(wv), x1 = bf_hi(wv);
#pragma unroll
          for (int i = 0; i < 16; ++i) { const int j = r - i; if (j >= 0 && j < 31) { o0[i] += x0 * w0[j]; o1[i] += x1 * w1[j]; } } }
#pragma unroll
      for (int i = 0; i < 16; ++i) *(LAS f32x2*)(lout + (16 * q + i) * 512 + 2 * p) = (f32x2){o0[i], o1[i]};
    }
    __syncthreads();
#pragma unroll 1
    for (int tt = 0; tt < 4; ++tt) { const int tl = F.wave * 4 + tt;
        const f32x4 a = *(const LAS f32x4*)(lout + tl * 512 + 4 * F.lane), b = *(const LAS f32x4*)(lout + tl * 512 + 256 + 4 * F.lane);
        float s = (a[0] + a[1]) + (a[2] + a[3]) + (b[0] + b[1]) + (b[2] + b[3]); s = wave_sum(s); const float mu = s * (1.0f / 512.0f);
        const f32x4 da = a - mu, db = b - mu; float q2 = (da[0] * da[0] + da[1] * da[1]) + (da[2] * da[2] + da[3] * da[3]) + (db[0] * db[0] + db[1] * db[1]) + (db[2] * db[2] + db[3] * db[3]);
        q2 = wave_sum(q2); const float rstd = 1.0f / sqrtf(q2 * (1.0f / 512.0f) + EPS);
        const f32x4 ga = *(const GAS f32x4*)(ln_g + 4 * F.lane), gb = *(const GAS f32x4*)(ln_g + 256 + 4 * F.lane), ba = *(const GAS f32x4*)(ln_b + 4 * F.lane), bb = *(const GAS f32x4*)(ln_b + 256 + 4 * F.lane);
        f32x4 ya = da * rstd * ga + ba, yb = db * rstd * gb + bb;
#pragma unroll
        for (int j = 0; j < 4; ++j) { ya[j] = ya[j] * sigmoidf_(ya[j]); yb[j] = yb[j] * sigmoidf_(yb[j]); }
        u32x2 wa, wb; wa.x = cvt_pk_bf16(ya[0], ya[1]); wa.y = cvt_pk_bf16(ya[2], ya[3]); wb.x = cvt_pk_bf16(yb[0], yb[1]); wb.y = cvt_pk_bf16(yb[2], yb[3]);
        bf16* orow = MIX + (size_t)(t0 + tl) * D;
        *(GAS u32x2*)(orow + 4 * F.lane) = wa; *(GAS u32x2*)(orow + 256 + 4 * F.lane) = wb; }
    __syncthreads();
}

__device__ __forceinline__ void attn_item(Frame& F, int i, int n, int h, const LAS float* rpbL) {
    const bf16* Q = (const bf16*)(F.ws + WS_Q); const bf16* Kp = (const bf16*)(F.ws + WS_K); const bf16* Vt = (const bf16*)(F.ws + WS_VT); bf16* MIX = (bf16*)(F.ws + WS_MIX);
    const int lane = F.lane, q = lane & 15, G = lane >> 4;
    const int qc = 16 * n + q, tokq = i * 64 + qc;
    const int r0 = min(max(i - 4, 0), NROWS - 8), bs = min(max(16 * n - 8, 0), 32);
    const bf16* qp = Q + (size_t)tokq * 512 + h * 64 + 8 * G;
    const bf16x8 Qf0 = *(const GAS bf16x8*)qp, Qf1 = *(const GAS bf16x8*)(qp + 32);
    const int kcl = 8 * (q >> 2) + (q & 3);
    bf16x8 Kf[8][2][2];
#pragma unroll
    for (int s = 0; s < 8; ++s)
#pragma unroll
        for (int odd = 0; odd < 2; ++odd) {
            const int tok = (r0 + s) * 64 + bs + kcl + 4 * odd; const bf16* kp = Kp + (size_t)tok * 512 + h * 64 + 8 * G;
            Kf[s][odd][0] = *(const GAS bf16x8*)kp; Kf[s][odd][1] = *(const GAS bf16x8*)(kp + 32); }
    __builtin_amdgcn_sched_barrier(0);
    f32x4 S[8][2];
#pragma unroll
    for (int s = 0; s < 8; ++s)
#pragma unroll
        for (int odd = 0; odd < 2; ++odd) {
            f32x4 a = (f32x4){0.f, 0.f, 0.f, 0.f};
            a = __builtin_amdgcn_mfma_f32_16x16x32_bf16(Kf[s][odd][0], Qf0, a, 0, 0, 0); a = __builtin_amdgcn_mfma_f32_16x16x32_bf16(Kf[s][odd][1], Qf1, a, 0, 0, 0);
            S[s][odd] = a; }
    bf16x8 Vf[4][4];
#pragma unroll
    for (int s = 0; s < 4; ++s) { const bf16* vb = Vt + ((size_t)((r0 + s) * 8 + h) * 64 + q) * 64 + bs + 8 * G;
#pragma unroll
        for (int d = 0; d < 4; ++d) Vf[s][d] = *(const GAS bf16x8*)(vb + d * 16 * 64); }
    __builtin_amdgcn_sched_barrier(0);
    const int c0 = min(max(qc - 8, 0), GRIDW - 16);
    const LAS float* rb = rpbL + h * 465;
    float mx = -1e30f;
#pragma unroll
    for (int s = 0; s < 8; ++s) { const int drow = r0 + s - i + 7;
#pragma unroll
        for (int odd = 0; odd < 2; ++odd)
#pragma unroll
            for (int r = 0; r < 4; ++r) { const int kc = bs + 8 * G + 4 * odd + r; const bool valid = (kc >= c0) && (kc < c0 + 16);
                const int dcol = min(max(kc - qc, -15), 15) + 15;
                float t = S[s][odd][r] * (0.125f * LOG2E) + rb[drow * 31 + dcol]; t = valid ? t : -1e30f; S[s][odd][r] = t; mx = fmaxf(mx, t); } }
    mx = fmaxf(mx, __shfl_xor(mx, 16)); mx = fmaxf(mx, __shfl_xor(mx, 32));
    float l = 0.f; bf16x8 Pf[8];
#pragma unroll
    for (int s = 0; s < 8; ++s) { float p[8];
#pragma unroll
        for (int odd = 0; odd < 2; ++odd)
#pragma unroll
            for (int r = 0; r < 4; ++r) { const float e = fast_exp2(S[s][odd][r] - mx); p[4 * odd + r] = e; l += e; }
        u32x4 w; w.x = cvt_pk_bf16(p[0], p[1]); w.y = cvt_pk_bf16(p[2], p[3]); w.z = cvt_pk_bf16(p[4], p[5]); w.w = cvt_pk_bf16(p[6], p[7]);
        Pf[s] = __builtin_bit_cast(bf16x8, w); }
    l += __shfl_xor(l, 16); l += __shfl_xor(l, 32);
    const float inv = 1.0f / l;
    f32x4 O[4];
#pragma unroll
    for (int d = 0; d < 4; ++d) O[d] = (f32x4){0.f, 0.f, 0.f, 0.f};
    bf16x8 Vg[4][4];
#pragma unroll
    for (int s = 0; s < 4; ++s) { const bf16* vb = Vt + ((size_t)((r0 + 4 + s) * 8 + h) * 64 + q) * 64 + bs + 8 * G;
#pragma unroll
        for (int d = 0; d < 4; ++d) Vg[s][d] = *(const GAS bf16x8*)(vb + d * 16 * 64); }
    __builtin_amdgcn_sched_barrier(0);
#pragma unroll
    for (int s = 0; s < 4; ++s)
#pragma unroll
        for (int d = 0; d < 4; ++d) O[d] = __builtin_amdgcn_mfma_f32_16x16x32_bf16(Vf[s][d], Pf[s], O[d], 0, 0, 0);
#pragma unroll
    for (int s = 0; s < 4; ++s)
#pragma unroll
        for (int d = 0; d < 4; ++d) O[d] = __builtin_amdgcn_mfma_f32_16x16x32_bf16(Vg[s][d], Pf[4 + s], O[d], 0, 0, 0);
    bf16* orow = MIX + (size_t)tokq * D + 512 + h * 64 + 4 * G;
#pragma unroll
    for (int d = 0; d < 4; ++d) { u32x2 w; w.x = cvt_pk_bf16(O[d][0] * inv, O[d][1] * inv); w.y = cvt_pk_bf16(O[d][2] * inv, O[d][3] * inv); *(GAS u32x2*)(orow + 16 * d) = w; }
}

__device__ __forceinline__ void p2_mixer(Frame& F, const float* conv_w, const float* conv_b, const float* ln_g, const float* ln_b, const float* rpb) {
    { const int p = F.tid & 255; float w0[31], w1[31];
#pragma unroll
      for (int j = 0; j < 31; ++j) { const f32x2 wv = *(const GAS f32x2*)(conv_w + j * 512 + 2 * p); w0[j] = wv.x; w1[j] = wv.y; }
      const f32x2 cb = *(const GAS f32x2*)(conv_b + 2 * p);
      for (int row = F.vcu; row < NROWS; row += F.G) { conv_unit(F, ln_g, ln_b, row * 64, w0, w1, cb.x, cb.y); conv_unit(F, ln_g, ln_b, row * 64 + 32, w0, w1, cb.x, cb.y); } }
    LAS float* rpbL = (LAS float*)F.lds;
    for (int p = F.tid; p < NHEAD * 465; p += 512) rpbL[p] = rpb[p] * LOG2E;
    __syncthreads();
    for (int row = F.vcu; row < NROWS; row += F.G)
#pragma unroll 1
        for (int n = 0; n < 4; ++n) attn_item(F, row, n, F.wave, rpbL);
    __syncthreads();
}

constexpr int RT_W = 0;
constexpr int RT_LOGIT = 73728;
constexpr int RT_HIST = RT_LOGIT + 8192;
__device__ __forceinline__ void p4_router(Frame& F, const float* w_router, const float* g_ffn, const float* b_router) {
    const float* h = F.out; const float* ssq = (const float*)(F.ws + WS_SSQ); float* rs2 = (float*)(F.ws + WS_RS2);
    unsigned* erank = (unsigned*)(F.ws + WS_ERANK); int* list = (int*)(F.ws + WS_LIST); float* glist = (float*)(F.ws + WS_GLIST);
    unsigned* gcount = (unsigned*)(F.ws + WS_CTL) + CW_GCOUNT;
    LAS float* wl = (LAS float*)(F.lds + RT_W); LAS float* logitL = (LAS float*)(F.lds + RT_LOGIT); LAS unsigned* hist = (LAS unsigned*)(F.lds + RT_HIST);
    const int lane = F.lane, th = lane >> 5, ks = lane & 31, g4 = lane >> 4, k16 = lane & 15;
    for (int blk = F.vcu; blk < T / 64; blk += F.G) {
        const int tb = blk * 64 + F.wave * 8 + th * 4;
        const int tg = blk * 64 + F.wave * 8 + g4 * 2;
        float acc[2][32];
#pragma unroll
        for (int a = 0; a < 2; ++a)
#pragma unroll
            for (int e = 0; e < 32; ++e) acc[a][e] = 0.f;
#pragma unroll 1
        for (int hf = 0; hf < 2; ++hf) {
            { f32x4 wv[8]; float gv[8];
#pragma unroll
              for (int i = 0; i < 8; ++i) { const int q = F.tid + 512 * i, kk = q >> 3; wv[i] = *(const GAS f32x4*)(w_router + (size_t)(hf * 512 + kk) * 32 + 4 * (q & 7)); gv[i] = g_ffn[hf * 512 + kk]; }
              __syncthreads();
#pragma unroll
              for (int i = 0; i < 8; ++i) { const int q = F.tid + 512 * i, kk = q >> 3; *(LAS f32x4*)(wl + kk * 36 + 4 * (q & 7)) = wv[i] * gv[i]; } }
            if (F.tid < 64) hist[F.tid] = 0u;
            __syncthreads();
            const float* hp0 = h + (size_t)tg * D + hf * 512 + 4 * k16; const float* hp1 = hp0 + D;
            f32x4 h0 = *(const GAS f32x4*)hp0, h1 = *(const GAS f32x4*)hp1;
#pragma unroll 1
            for (int cc = 0; cc < 8; ++cc) { const int kb = 4 * (k16 + 16 * cc); const int cn = cc < 7 ? cc + 1 : cc;
                const f32x4 n0 = *(const GAS f32x4*)(hp0 + 64 * cn), n1 = *(const GAS f32x4*)(hp1 + 64 * cn);
#pragma unroll
                for (int c = 0; c < 4; ++c) {
#pragma unroll
                    for (int e4 = 0; e4 < 8; ++e4) { const f32x4 w = *(const LAS f32x4*)(wl + (kb + c) * 36 + 4 * e4);
#pragma unroll
                        for (int j = 0; j < 4; ++j) { acc[0][4 * e4 + j] += h0[c] * w[j]; acc[1][4 * e4 + j] += h1[c] * w[j]; } } }
                h0 = n0; h1 = n1; }
        }
        float r32[32], r16[16], r8[8], r4[4];
#pragma unroll
        for (int i = 0; i < 32; ++i) { const bool up = (lane & 8) != 0; const float send = up ? acc[0][i] : acc[1][i], keep = up ? acc[1][i] : acc[0][i]; r32[i] = keep + __shfl_xor(send, 8); }
#pragma unroll
        for (int i = 0; i < 16; ++i) { const bool up = (lane & 4) != 0; const float send = up ? r32[i] : r32[i + 16], keep = up ? r32[i + 16] : r32[i]; r16[i] = keep + __shfl_xor(send, 4); }
#pragma unroll
        for (int i = 0; i < 8; ++i) { const bool up = (lane & 2) != 0; const float send = up ? r16[i] : r16[i + 8], keep = up ? r16[i + 8] : r16[i]; r8[i] = keep + __shfl_xor(send, 2); }
#pragma unroll
        for (int i = 0; i < 4; ++i) { const bool up = (lane & 1) != 0; const float send = up ? r8[i] : r8[i + 4], keep = up ? r8[i + 4] : r8[i]; r4[i] = keep + __shfl_xor(send, 1); }
        *(LAS f32x4*)(logitL + (F.wave * 8 + g4 * 2 + (k16 >> 3)) * 32 + 4 * (k16 & 7)) = (f32x4){r4[0], r4[1], r4[2], r4[3]};
        LDS_WAIT(); asm volatile("" ::: "memory");
        int myE[4]; float myG[4]; unsigned myR[4];
#pragma unroll
        for (int a = 0; a < 4; ++a) { const int tok = tb + a;
            float sp = ks < 16 ? ssq[(size_t)tok * 16 + ks] : 0.f;
#pragma unroll
            for (int o = 1; o < 16; o <<= 1) sp += __shfl_xor(sp, o);
            sp = __shfl(sp, lane & 32);
            const float rs = 1.0f / sqrtf(sp * (1.0f / D) + EPS);
            if (ks == 0) rs2[tok] = rs;
            const float v = logitL[(F.wave * 8 + th * 4 + a) * 32 + ks] * rs + b_router[ks];
            bool taken = false; float tv[4]; int ti[4];
#pragma unroll
            for (int r = 0; r < 4; ++r) { float bv = taken ? -3.0e38f : v; int bi = ks;
#pragma unroll
                for (int o = 1; o < 32; o <<= 1) { const float ov = __shfl_xor(bv, o); const int oi = __shfl_xor(bi, o); if (ov > bv || (ov == bv && oi < bi)) { bv = ov; bi = oi; } }
                tv[r] = bv; ti[r] = bi; if (bi == ks) taken = true; }
            const float e1 = __expf(tv[1] - tv[0]), e2 = __expf(tv[2] - tv[0]), e3 = __expf(tv[3] - tv[0]); const float inv = 1.0f / (1.0f + e1 + e2 + e3);
            const float gsel = ks == 0 ? inv : (ks == 1 ? e1 * inv : (ks == 2 ? e2 * inv : e3 * inv)); const int esel = ks == 0 ? ti[0] : (ks == 1 ? ti[1] : (ks == 2 ? ti[2] : ti[3]));
            myE[a] = esel; myG[a] = gsel; myR[a] = 0u;
            if (ks < 4) myR[a] = __hip_atomic_fetch_add(hist + esel, 1u, __ATOMIC_RELAXED, __HIP_MEMORY_SCOPE_WORKGROUP); }
        __syncthreads();
        if (F.tid < 32) hist[32 + F.tid] = __hip_atomic_fetch_add(gcount + F.tid, hist[F.tid], RLX_AGENT);
        __syncthreads();
        if (ks < 4) {
#pragma unroll
            for (int a = 0; a < 4; ++a) { const unsigned rank = hist[32 + myE[a]] + myR[a]; const int tok = tb + a;
                list[myE[a] * 16384 + rank] = tok; glist[myE[a] * 16384 + rank] = myG[a]; erank[tok * 4 + ks] = ((unsigned)myE[a] << 16) | rank; } }
    }
    __syncthreads();
}

__device__ __forceinline__ int grouped_setup(Frame& F, int ntn, bool gate_mode, const float* bias0, const float* bias1) {
    LAS int* tile = (LAS int*)(F.lds + AT_TILE); LAS int* offs = (LAS int*)(F.lds + AT_OFFS);
    LAS unsigned* tokoff = (LAS unsigned*)(F.lds + AT_TOK); LAS float* rowf = (LAS float*)(F.lds + AT_ROWF); LAS float* biasL = (LAS float*)(F.lds + AT_BIAS);
    const unsigned* gcount = (const unsigned*)(F.ws + WS_CTL) + CW_GCOUNT;
    const int* list = (const int*)(F.ws + WS_LIST); const float* glist = (const float*)(F.ws + WS_GLIST); const float* rs2 = (const float*)(F.ws + WS_RS2);
    __syncthreads();
    if (F.tid == 0) { int o = 0, nt = 0;
        for (int e = 0; e < NE; ++e) { const int c = (int)gcount[e]; offs[e] = o; offs[33 + e] = c; o += c; const int k = (c + 255) >> 8; for (int j = 0; j < k; ++j) tile[nt++] = (e << 16) | j; }
        offs[32] = o; offs[70] = nt; }
    __syncthreads();
    const int ntiles = offs[70];
    for (int i = 0; i < MAXU; ++i) { const int L = i * F.G + (int)blockIdx.x; if (L >= ntiles * ntn) break;
        const int mt = L / ntn, pn = L - mt * ntn, te = tile[mt], e = te >> 16, j = te & 0xffff, cnt = offs[33 + e];
        if (F.tid >= 256) { const int c = F.tid - 256;
            biasL[i * 256 + c] = gate_mode ? bias0[e * D + pn * 256 + c] : (c < 128 ? bias0[e * DFF + pn * 128 + c] : bias1[e * DFF + pn * 128 + c - 128]); }
        for (int r = F.tid; r < 256; r += 512) { const int pos = 256 * j + r; const bool ok = pos < cnt;
            if (gate_mode) rowf[i * 256 + r] = ok ? glist[e * 16384 + pos] : 0.f;
            else { const int tok = ok ? list[e * 16384 + pos] : 0; tokoff[i * 256 + r] = (unsigned)tok * (unsigned)D; rowf[i * 256 + r] = rs2[tok] * (1.0f / (SA * SW)); } } }
    __syncthreads();
    return ntiles;
}

__device__ __forceinline__ void p7_combine(Frame& F, const float* g_final) {
    const unsigned* gcount = (const unsigned*)(F.ws + WS_CTL) + CW_GCOUNT; const unsigned* erank = (const unsigned*)(F.ws + WS_ERANK); const bf16* Y = (const bf16*)(F.ws + WS_Y);
    LAS int* offs = (LAS int*)(F.lds + AT_OFFS);
    __syncthreads();
    if (F.tid == 0) { int o = 0; for (int e = 0; e < NE; ++e) { offs[e] = o; o += (int)gcount[e]; } }
    __syncthreads();
    const int gw = F.vcu * 8 + F.wave, NGW = F.G * 8;
    f32x4 gf[4];
#pragma unroll
    for (int j = 0; j < 4; ++j) gf[j] = *(const GAS f32x4*)(g_final + (j >> 1) * 512 + 8 * F.lane + 4 * (j & 1));
    for (int t0 = gw; t0 < T; t0 += 2 * NGW) {
        const int tt[2] = {t0, t0 + NGW};
        f32x4 v[2][4]; u32x4 y[2][4][2];
#pragma unroll
        for (int a = 0; a < 2; ++a) { const int t = tt[a] < T ? tt[a] : t0;
            const u32x4 er = *(const GAS u32x4*)(erank + t * 4);
            size_t pos[4];
            pos[0] = (size_t)(offs[er.x >> 16] + (int)(er.x & 0xffffu)); pos[1] = (size_t)(offs[er.y >> 16] + (int)(er.y & 0xffffu));
            pos[2] = (size_t)(offs[er.z >> 16] + (int)(er.z & 0xffffu)); pos[3] = (size_t)(offs[er.w >> 16] + (int)(er.w & 0xffffu));
            const float* hrow = F.out + (size_t)t * D;
#pragma unroll
            for (int j = 0; j < 4; ++j) v[a][j] = *(const GAS f32x4*)(hrow + (j >> 1) * 512 + 8 * F.lane + 4 * (j & 1));
#pragma unroll
            for (int r = 0; r < 4; ++r)
#pragma unroll
                for (int hh = 0; hh < 2; ++hh) y[a][r][hh] = *(const GAS u32x4*)(Y + pos[r] * D + hh * 512 + 8 * F.lane); }
#pragma unroll
        for (int a = 0; a < 2; ++a) { if (tt[a] >= T) break;
            float s = 0.f;
#pragma unroll
            for (int r = 0; r < 4; ++r)
#pragma unroll
                for (int hh = 0; hh < 2; ++hh) { const u32x4 w = y[a][r][hh];
                    v[a][2 * hh][0] += bf_lo(w.x); v[a][2 * hh][1] += bf_hi(w.x); v[a][2 * hh][2] += bf_lo(w.y); v[a][2 * hh][3] += bf_hi(w.y);
                    v[a][2 * hh + 1][0] += bf_lo(w.z); v[a][2 * hh + 1][1] += bf_hi(w.z); v[a][2 * hh + 1][2] += bf_lo(w.w); v[a][2 * hh + 1][3] += bf_hi(w.w); }
#pragma unroll
            for (int j = 0; j < 4; ++j) s += (v[a][j][0] * v[a][j][0] + v[a][j][1] * v[a][j][1]) + (v[a][j][2] * v[a][j][2] + v[a][j][3] * v[a][j][3]);
            s = wave_sum(s); const float rs = 1.0f / sqrtf(s * (1.0f / D) + EPS);
            float* orow = F.out + (size_t)tt[a] * D;
#pragma unroll
            for (int j = 0; j < 4; ++j) *(GAS f32x4*)(orow + (j >> 1) * 512 + 8 * F.lane + 4 * (j & 1)) = v[a][j] * rs * gf[j]; }
    }
}

constexpr int NPHASE = 8;
struct Args { const float* in[21]; float* out; unsigned char* ws; int ph_lo, ph_hi; };
__global__ void __launch_bounds__(512, 2) enc_fwd(Args args) {
    extern __shared__ __attribute__((aligned(16))) unsigned char lds[];
    Frame F;
    F.lds = (LAS unsigned char*)lds;
    F.tid = threadIdx.x; F.lane = F.tid & 63; F.wave = __builtin_amdgcn_readfirstlane(F.tid >> 6);
    F.G = gridDim.x; { const int bx = blockIdx.x; F.vcu = (F.G % 8 == 0) ? (bx % 8) * (F.G / 8) + bx / 8 : bx; }
    F.out = args.out; F.ws = args.ws;
    volatile LAS unsigned* MISC = (volatile LAS unsigned*)(F.lds + MISC_OFF);
    if (F.tid < 64) MISC[F.tid] = 0u;
    __syncthreads();
    const int lo = args.ph_lo, hi = args.ph_hi;
    const bool use_bar = (hi - lo) > 1;
    XcdBarrier bar; bar.bar = (unsigned*)(F.ws + WS_CTL) + CW_BAR; bar.x = 0; bar.st = nullptr;
    if (use_bar) bar = xcd_barrier_post((unsigned*)(F.ws + WS_CTL) + CW_BAR, MISC + 8);
#ifndef PH_MASK
#define PH_MASK 0xff
#endif
#define IN(k) (((PH_MASK >> (k)) & 1) && lo <= (k) && (k) < hi)
#define SEAM(k) do { if (IN(k) && IN((k) + 1)) xcd_barrier(bar); } while (0)

    if (IN(0)) { P0Ptrs P{args.in[0], args.in[1], args.in[2], args.in[9], args.in[11], args.in[14], args.in[16], args.in[18]}; p0_prologue(F, P); SEAM(0); }

    if (IN(1)) {
        { pg8::StaticOrder S; S.init(F.ws + WS_XB, F.ws + WS_WIN, T, 2048, D * 2, F.G, (int)blockIdx.x);
          EpiInProj E{(const float*)(F.ws + WS_RS1), args.in[3], (bf16*)(F.ws + WS_U), (bf16*)(F.ws + WS_Q), (bf16*)(F.ws + WS_K)};
          pg8::gemm_phase<EpiInProj, pg8::StaticOrder>(F.lds, D * 2, S, E); }
        { pg8::StaticOrder S; S.init(F.ws + WS_WIN + (size_t)2048 * D * 2, F.ws + WS_XB, 512, T, D * 2, F.G, (int)blockIdx.x);
          EpiVt E{(const float*)(F.ws + WS_RS1), args.in[3] + 2048, (bf16*)(F.ws + WS_VT)};
          pg8::gemm_phase<EpiVt, pg8::StaticOrder>(F.lds, D * 2, S, E); }
        SEAM(1);
    }

    if (IN(2)) { p2_mixer(F, args.in[4], args.in[5], args.in[6], args.in[7], args.in[8]); SEAM(2); }

    if (IN(3)) {
        pg8::StaticOrder S; S.init(F.ws + WS_MIX, F.ws + WS_WOUT, T, D, D * 2, F.G, (int)blockIdx.x);
        EpiOut E{args.in[0], args.in[10], F.out, F.ws + WS_H8, (float*)(F.ws + WS_SSQ)};
        pg8::gemm_phase<EpiOut, pg8::StaticOrder>(F.lds, D * 2, S, E);
        SEAM(3);
    }

    if (IN(4)) { p4_router(F, args.in[12], args.in[11], args.in[13]); SEAM(4); }

    if (IN(5)) {
        const int ntiles = grouped_setup(F, 8, false, args.in[15], args.in[17]);
        pg8::GroupedOrder<true> S; S.A = (const char*)(F.ws + WS_H8); S.Bt = (const char*)(F.ws + WS_WGU); S.KB = D; S.ntn = 8; S.Nexp = 2048; S.G = F.G; S.c = (int)blockIdx.x; S.ntiles = ntiles;
        S.tile = (const LAS int*)(F.lds + AT_TILE); S.offs = (const LAS int*)(F.lds + AT_OFFS); S.tokoff = (const LAS unsigned*)(F.lds + AT_TOK);
        EpiGU E{&S, (const LAS float*)(F.lds + AT_ROWF), (const LAS float*)(F.lds + AT_BIAS), F.ws + WS_HD};
        pg8::gemm_phase<EpiGU, pg8::GroupedOrder<true>, true>(F.lds, D, S, E);
        SEAM(5);
    }

    if (IN(6)) {
        const int ntiles = grouped_setup(F, 4, true, args.in[19], nullptr);
        pg8::GroupedOrder<false> S; S.A = (const char*)(F.ws + WS_HD); S.Bt = (const char*)(F.ws + WS_WD); S.KB = DFF; S.ntn = 4; S.Nexp = 1024; S.G = F.G; S.c = (int)blockIdx.x; S.ntiles = ntiles;
        S.tile = (const LAS int*)(F.lds + AT_TILE); S.offs = (const LAS int*)(F.lds + AT_OFFS); S.tokoff = (const LAS unsigned*)(F.lds + AT_TOK);
        EpiDown E{&S, (const LAS float*)(F.lds + AT_ROWF), (const LAS float*)(F.lds + AT_BIAS), (bf16*)(F.ws + WS_Y)};
        pg8::gemm_phase<EpiDown, pg8::GroupedOrder<false>, true>(F.lds, DFF, S, E);
        SEAM(6);
    }

    if (IN(7)) { p7_combine(F, args.in[20]); }
#undef IN
#undef SEAM
}

extern "C" void kernel_launch(void* const* d_in, const int* in_sizes, int n_in, void* d_out, int out_size, void* d_ws, size_t ws_size, hipStream_t stream) {
    static int grid = 0;
    if (grid == 0) {
        if (n_in != 21 || out_size != T * D || ws_size < WS_END) { fprintf(stderr, "kernel_launch: unexpected problem (n_in %d, out %d, ws %zu)\n", n_in, out_size, ws_size); grid = -1; return; }
        int dev = 0, cus = 0, per_cu = 0;
        if (hipGetDevice(&dev) != hipSuccess || hipDeviceGetAttribute(&cus, hipDeviceAttributeMultiprocessorCount, dev) != hipSuccess) { grid = -1; return; }
        if (hipFuncSetAttribute((const void*)enc_fwd, hipFuncAttributeMaxDynamicSharedMemorySize, LDS_BYTES) != hipSuccess) { fprintf(stderr, "kernel_launch: cannot set %d bytes of dynamic LDS\n", LDS_BYTES); grid = -1; return; }
        if (hipOccupancyMaxActiveBlocksPerMultiprocessor(&per_cu, (const void*)enc_fwd, 512, LDS_BYTES) != hipSuccess || per_cu < 1) { fprintf(stderr, "kernel_launch: occupancy query says %d\n", per_cu); (void)hipGetLastError(); per_cu = 1; }
        grid = cus;
        if (grid != 256) { fprintf(stderr, "kernel_launch: built for a 256-CU device, got %d CUs\n", cus); grid = -1; return; }
    }
    if (grid < 0) return;
    (void)hipMemsetAsync((char*)d_ws + WS_CTL, 0, CTL_ZERO_BYTES, stream);
    Args a{};
    for (int i = 0; i < 21; ++i) a.in[i] = (const float*)d_in[i];
    a.out = (float*)d_out; a.ws = (unsigned char*)d_ws;
    if (MK_N_LAUNCHES == 1) { a.ph_lo = 0; a.ph_hi = NPHASE; hipLaunchKernelGGL(enc_fwd, dim3(grid), dim3(512), LDS_BYTES, stream, a); }
    else { for (int p = 0; p < NPHASE; ++p) { a.ph_lo = p; a.ph_hi = p + 1; hipLaunchKernelGGL(enc_fwd, dim3(grid), dim3(512), LDS_BYTES, stream, a); } }
}
```

```cpp
#include <hip/hip_runtime.h>
#include <cstdio>
#include <cstdint>

#ifndef MK_N_LAUNCHES
#define MK_N_LAUNCHES 1
#endif

#define GAS __attribute__((address_space(1)))
#define LAS __attribute__((address_space(3)))
typedef unsigned short bf16;
typedef short bf16x8 __attribute__((ext_vector_type(8)));
typedef float f32x4 __attribute__((ext_vector_type(4)));
typedef float f32x2 __attribute__((ext_vector_type(2)));
typedef unsigned u32x4 __attribute__((ext_vector_type(4)));
typedef unsigned u32x2 __attribute__((ext_vector_type(2)));

constexpr int T = 16384, D = 1024, GRIDW = 64, NROWS = 256;
constexpr int DC = 512, CONVK = 31, NHEAD = 8, HDIM = 64, DIN = 2560;
constexpr int NE = 32, DFF = 1024, TK = T * 4;
constexpr float EPS = 1e-5f;
constexpr float LOG2E = 1.4426950408889634f;

constexpr size_t MiB = 1u << 20;
constexpr size_t WS_CTL = 0, CTL_ZERO_BYTES = 65536;
constexpr size_t WS_WIN = 1 * MiB;
constexpr size_t WS_WOUT = 6 * MiB;
constexpr size_t WS_WGU = 8 * MiB;
constexpr size_t WS_WD = 72 * MiB;
constexpr size_t WS_H8 = 104 * MiB;
constexpr size_t WS_RS1 = 120 * MiB;
constexpr size_t WS_SSQ = WS_RS1 + 65536;
constexpr size_t WS_RS2 = WS_SSQ + 1 * MiB;
constexpr size_t WS_ERANK = WS_RS2 + 65536;
constexpr size_t WS_LIST = 122 * MiB;
constexpr size_t WS_GLIST = 124 * MiB;
constexpr size_t WS_OVL = 128 * MiB;
constexpr size_t WS_XB = WS_OVL;
constexpr size_t WS_U = WS_OVL + 32 * MiB;
constexpr size_t WS_Q = WS_OVL + 48 * MiB;
constexpr size_t WS_K = WS_OVL + 64 * MiB;
constexpr size_t WS_VT = WS_OVL + 80 * MiB;
constexpr size_t WS_MIX = WS_OVL + 96 * MiB;
constexpr size_t WS_HD = WS_OVL;
constexpr size_t WS_Y = 258 * MiB;
constexpr size_t WS_END = 386 * MiB;
static_assert(WS_HD + (size_t)(TK + 256) * DFF <= WS_Y && WS_MIX + (size_t)T * D * 2 <= WS_Y && WS_ERANK + (size_t)TK * 4 <= WS_LIST, "ws map");
constexpr float SA = 16.0f, SW = 1024.0f, SH = 4.0f, SY = 32.0f;

constexpr int CW_TMO = 0, CW_BAR = 4096, CW_GCOUNT = 8192;

constexpr int RING_BYTES = 131072;
constexpr int AUX_OFF = RING_BYTES;
constexpr int MISC_OFF = AUX_OFF;
constexpr int AUX_TAB = AUX_OFF + 256;
constexpr int LDS_BYTES = 163840;
constexpr int MAXU = 9;
constexpr int MAXTILES = 288;
constexpr int AT_TOK = AUX_TAB;
constexpr int AT_ROWF = AT_TOK + MAXU * 1024;
constexpr int AT_TILE = AT_ROWF + MAXU * 1024;
constexpr int AT_OFFS = AT_TILE + MAXTILES * 4;
constexpr int AT_BIAS = AT_OFFS + 80 * 4;
constexpr int AT_END = AT_BIAS + MAXU * 1024;
static_assert(AT_END <= LDS_BYTES, "LDS aux map");

#define RLX_AGENT __ATOMIC_RELAXED, __HIP_MEMORY_SCOPE_AGENT
#define LDS_WAIT() asm volatile("s_waitcnt lgkmcnt(0)" ::: "memory")
#define VM_WAIT() asm volatile("s_waitcnt vmcnt(0)" ::: "memory")

__device__ __forceinline__ unsigned cvt_pk_bf16(float lo, float hi) { unsigned r; asm volatile("v_cvt_pk_bf16_f32 %0, %1, %2" : "=v"(r) : "v"(lo), "v"(hi)); return r; }
__device__ __forceinline__ float clamp8(float v) { return __builtin_fminf(__builtin_fmaxf(v, -448.0f), 448.0f); }
__device__ __forceinline__ unsigned pk4_fp8(float a, float b, float c, float d) { unsigned w = __builtin_amdgcn_cvt_pk_fp8_f32(clamp8(a), clamp8(b), 0u, false); return __builtin_amdgcn_cvt_pk_fp8_f32(clamp8(c), clamp8(d), w, true); }
__device__ __forceinline__ float bf_lo(unsigned w) { return __uint_as_float(w << 16); }
__device__ __forceinline__ float bf_hi(unsigned w) { return __uint_as_float(w & 0xffff0000u); }
__device__ __forceinline__ float fast_exp2(float x) { return __builtin_amdgcn_exp2f(x); }
__device__ __forceinline__ float fast_rcp(float x) { return __builtin_amdgcn_rcpf(x); }
__device__ __forceinline__ float sigmoidf_(float x) { return fast_rcp(1.0f + fast_exp2(-LOG2E * x)); }

namespace pg8 {
constexpr int BM = 256, BK = 64, HALF = 128, HTB = HALF * BK * 2, STAGE_BYTES = 8 * HTB, NXCD = 8, WGM = 8;
__host__ __device__ __forceinline__ int lds_byte(int r, int c) { const int st = (r >> 4) * 2 + (c >> 5), rr = r & 15, cc = c & 31, ob = rr * 64 + cc * 2; return st * 1024 + (ob ^ (((ob >> 9) & 1) << 5)); }
__host__ __device__ __forceinline__ void stage_rc(int b, int& R, int& C) { const int st = b / 1024, sb = b % 1024, swz = sb ^ (((sb >> 9) & 1) << 5); R = (st >> 1) * 16 + swz / 64; C = (st & 1) * 32 + (swz % 64) / 2; }
__host__ __device__ __forceinline__ int perm32(int rho) { const int n = rho >> 4, i = rho & 15; return 8 * (i >> 2) + 4 * n + (i & 3); }

typedef int i32x8 __attribute__((ext_vector_type(8))); typedef int i32x4v __attribute__((ext_vector_type(4)));
__device__ __forceinline__ i32x8 cat8(bf16x8 a, bf16x8 b) { return __builtin_shufflevector(__builtin_bit_cast(i32x4v, a), __builtin_bit_cast(i32x4v, b), 0, 1, 2, 3, 4, 5, 6, 7); }
struct Unit { const char* A; const char* B; int pm, pn, slot; };

struct StaticOrder {
    static constexpr bool GATHER = false;
    const char* A; const char* Bt; int KB  ; int nM, nN, nwg, G, c;
    __device__ void init(const void* A_, const void* Bt_, int M, int N, int KB_, int G_, int c_) { A = (const char*)A_; Bt = (const char*)Bt_; KB = KB_; nM = M / BM; nN = N / BM; nwg = nM * nN; G = G_; c = c_; }
    __device__ __forceinline__ bool next(int i, Unit& u) const {
        const long L = (long)i * G + c; if (L >= nwg) return false;
        int wgid = (int)L; { const int q = nwg / NXCD, r = nwg % NXCD, xcd = wgid % NXCD, off = wgid / NXCD; wgid = (xcd < r ? xcd * (q + 1) : r * (q + 1) + (xcd - r) * q) + off; }
        const int nig = WGM * nN, gid = wgid / nig, fm = gid * WGM, gsz = (nM - fm) < WGM ? (nM - fm) : WGM;
        u.pm = fm + ((wgid % nig) % gsz); u.pn = (wgid % nig) / gsz;
        u.A = A + (size_t)u.pm * BM * KB; u.B = Bt + (size_t)u.pn * BM * KB; u.slot = 0; return true;
    }
    __device__ __forceinline__ void voff(const Unit&, unsigned (&v)[2][2]) const {
#pragma unroll
        for (int i = 0; i < 2; ++i) { int R, C; stage_rc((int)threadIdx.x * 16 + i * 8192, R, C);
#pragma unroll
            for (int h = 0; h < 2; ++h) v[h][i] = (unsigned)((R + HALF * h) * KB + C * 2); }
    }
};

template <bool GATHER_> struct GroupedOrder {
    static constexpr bool GATHER = GATHER_;
    const char* A; const char* Bt; int KB  ; int ntn, Nexp  , G, c, ntiles;
    const LAS int* tile; const LAS int* offs; const LAS unsigned* tokoff;
    __device__ __forceinline__ bool next(int i, Unit& u) const {
        const int L = i * G + c; if (L >= ntiles * ntn) return false;
        const int mt = L / ntn; u.pn = L - mt * ntn; const int te = tile[mt], e = te >> 16, j = te & 0xffff;
        u.pm = mt; u.slot = i;
        u.A = GATHER ? A : A + (size_t)(offs[e] + 256 * j) * KB;
        u.B = Bt + ((size_t)e * Nexp + (size_t)u.pn * BM) * KB; return true;
    }
    __device__ __forceinline__ void voff(const Unit& u, unsigned (&v)[2][2]) const {
#pragma unroll
        for (int i = 0; i < 2; ++i) { int R, C; stage_rc((int)threadIdx.x * 16 + i * 8192, R, C);
#pragma unroll
            for (int h = 0; h < 2; ++h) v[h][i] = GATHER ? tokoff[u.slot * 256 + R + HALF * h] + (unsigned)C * 2u : (unsigned)((R + HALF * h) * KB + C * 2); }
    }
    __device__ __forceinline__ void meta(const Unit& u, int& e, int& row0, int& nvalid) const { const int te = tile[u.pm]; e = te >> 16; const int j = te & 0xffff; row0 = offs[e] + 256 * j; const int rem = offs[33 + e] - 256 * j; nvalid = rem < 256 ? rem : 256; }
};

template <class Epi, class Sched, bool FP8 = false, bool ALIGN_EPI = true>
__device__ __forceinline__ void gemm_phase(LAS unsigned char* lds, const int KB, const Sched& S, const Epi& E) {
    const int tid = threadIdx.x, wid = __builtin_amdgcn_readfirstlane(tid >> 6), lane = tid & 63, wr = wid >> 2, wc = wid & 3, fr = lane & 15, fq = lane >> 4;
    const int nt = KB / (BK * 2);
    unsigned voffB[2];
#pragma unroll
    for (int i = 0; i < 2; ++i) { int R, C; stage_rc(tid * 16 + i * 8192, R, C); const int Rb = (R & ~31) + perm32(R & 31); voffB[i] = (unsigned)(Rb * KB + C * 2); }
    const size_t kstep = (size_t)(BK * 2);
    const size_t hstep = (size_t)HALF * KB;
    const unsigned ldsw = (unsigned)wid * 1024u;
    const int aoff = lds_byte(wr * 64 + fr, fq * 8), boff = lds_byte(wc * 32 + fr, fq * 8);
#define PG8_SA(b, h) (((b) * 2 + (h)) * HTB)
#define PG8_SB(b, h) ((4 + (b) * 2 + (h)) * HTB)
#define PG8_STAGE2(bufoff, gbase, v0, v1) do { \
        __builtin_amdgcn_global_load_lds((const unsigned*)((const char*)(gbase) + (v0)), (LAS unsigned*)(lds + (bufoff) + ldsw), 16, 0, 0); \
        __builtin_amdgcn_global_load_lds((const unsigned*)((const char*)(gbase) + (v1)), (LAS unsigned*)(lds + (bufoff) + ldsw + 8192), 16, 0, 0); } while (0)
#define PG8_STAGEB(bufoff, gbase) PG8_STAGE2(bufoff, gbase, voffB[0], voffB[1])
#define PG8_LDA(dst, b, h) do { _Pragma("unroll") for (int m = 0; m < 4; ++m) _Pragma("unroll") for (int k = 0; k < 2; ++k) dst[m][k] = *(const LAS bf16x8*)(lds + PG8_SA(b, h) + aoff + m * 2048 + k * 1024); } while (0)
#define PG8_LDB(dst, b, h) do { _Pragma("unroll") for (int n = 0; n < 2; ++n) _Pragma("unroll") for (int k = 0; k < 2; ++k) dst[n][k] = *(const LAS bf16x8*)(lds + PG8_SB(b, h) + boff + n * 2048 + k * 1024); } while (0)
#define PG8_MMA(ai, bj, At, Bt) do { __builtin_amdgcn_s_setprio(1); _Pragma("unroll") for (int m = 0; m < 4; ++m) _Pragma("unroll") for (int n = 0; n < 2; ++n) { \
        if constexpr (FP8) { const i32x8 b8_ = cat8(Bt[n][0], Bt[n][1]), a8_ = cat8(At[m][0], At[m][1]); \
            asm volatile("v_mfma_scale_f32_16x16x128_f8f6f4 %0, %1, %2, %0, %3, %3 op_sel_hi:[0,0,0]" : "+v"(acc[ai][bj][m][n]) : "v"(b8_), "v"(a8_), "v"(scl)); } \
        else { _Pragma("unroll") for (int k = 0; k < 2; ++k) acc[ai][bj][m][n] = __builtin_amdgcn_mfma_f32_16x16x32_bf16(Bt[n][k], At[m][k], acc[ai][bj][m][n], 0, 0, 0); } } \
        __builtin_amdgcn_s_setprio(0); } while (0)
#define PG8_WAIT_V(n) asm volatile("s_waitcnt vmcnt(" #n ")" ::: "memory")
#define PG8_WAIT_L(n) asm volatile("s_waitcnt lgkmcnt(" #n ")" ::: "memory")
#define PG8_BAR __builtin_amdgcn_s_barrier()
#define PG8_SCHED __builtin_amdgcn_sched_barrier(0)
    Unit cur, nxt; int ui = 0;
    if (!S.next(0, cur)) return;
    unsigned scl = 0x7f7f7f7fu; asm volatile("" : "+v"(scl));
    unsigned vAc[2][2];
    S.voff(cur, vAc);
    f32x4 acc[2][2][4][2];
#pragma unroll
    for (int a = 0; a < 2; ++a)
#pragma unroll
        for (int b = 0; b < 2; ++b)
#pragma unroll
            for (int m = 0; m < 4; ++m)
#pragma unroll
                for (int n = 0; n < 2; ++n) acc[a][b][m][n] = (f32x4){0.f, 0.f, 0.f, 0.f};
    bf16x8 At[4][2], B0[2][2], B1[2][2];
    const char* cA = cur.A; const char* cB = cur.B;
    PG8_STAGEB(PG8_SB(0, 0), cB); PG8_STAGEB(PG8_SB(0, 1), cB + hstep); PG8_STAGE2(PG8_SA(0, 0), cA, vAc[0][0], vAc[0][1]); PG8_STAGE2(PG8_SA(0, 1), cA, vAc[1][0], vAc[1][1]);
    if (wr == 1) PG8_BAR;
    PG8_WAIT_V(2); PG8_BAR;
    PG8_STAGEB(PG8_SB(1, 0), cB + kstep); PG8_STAGE2(PG8_SA(1, 0), cA + kstep, vAc[0][0], vAc[0][1]); PG8_STAGEB(PG8_SB(1, 1), cB + hstep + kstep);
    PG8_WAIT_V(6); PG8_BAR;
    for (;;) {
        const bool has_next = S.next(ui + 1, nxt);
        const char* nA = has_next ? nxt.A : cA; const char* nB = has_next ? nxt.B : cB;
#pragma unroll 1
        for (int t = 0; t < nt; t += 2) {
            const bool last = (t == nt - 2);
            const char* a1 = cA + (size_t)(t + 1) * kstep;
            const char* a2 = last ? nA : cA + (size_t)(t + 2) * kstep; const char* b2 = last ? nB : cB + (size_t)(t + 2) * kstep;
            const char* a3 = a2 + kstep; const char* b3 = b2 + kstep;
            unsigned w00 = vAc[0][0], w01 = vAc[0][1], w10 = vAc[1][0], w11 = vAc[1][1];
            if constexpr (Sched::GATHER) { if (last && has_next) { unsigned vn[2][2]; S.voff(nxt, vn); w00 = vn[0][0]; w01 = vn[0][1]; w10 = vn[1][0]; w11 = vn[1][1]; } }
            PG8_LDB(B0, 0, 0); PG8_LDB(B1, 0, 1); PG8_SCHED; PG8_LDA(At, 0, 0); PG8_STAGE2(PG8_SA(1, 1), a1, vAc[1][0], vAc[1][1]);
            PG8_WAIT_V(8); PG8_WAIT_L(0); PG8_BAR; PG8_MMA(0, 0, At, B0); PG8_MMA(0, 1, At, B1); PG8_BAR; PG8_SCHED;
            PG8_LDA(At, 0, 1); PG8_STAGEB(PG8_SB(0, 0), b2); PG8_STAGEB(PG8_SB(0, 1), b2 + hstep); PG8_STAGE2(PG8_SA(0, 0), a2, w00, w01);
            PG8_WAIT_V(8); PG8_WAIT_L(0); PG8_BAR; PG8_MMA(1, 0, At, B0); PG8_MMA(1, 1, At, B1); PG8_BAR; PG8_SCHED;
            PG8_LDB(B0, 1, 0); PG8_LDB(B1, 1, 1); PG8_SCHED; PG8_LDA(At, 1, 0); PG8_STAGE2(PG8_SA(0, 1), a2, w10, w11);
            PG8_WAIT_V(8); PG8_WAIT_L(0); PG8_BAR; PG8_MMA(0, 0, At, B0); PG8_MMA(0, 1, At, B1); PG8_BAR; PG8_SCHED;
            PG8_LDA(At, 1, 1); PG8_STAGEB(PG8_SB(1, 0), b3); PG8_STAGEB(PG8_SB(1, 1), b3 + hstep); PG8_STAGE2(PG8_SA(1, 0), a3, w00, w01);
            PG8_WAIT_V(8); PG8_WAIT_L(0); PG8_BAR; PG8_MMA(1, 0, At, B0); PG8_MMA(1, 1, At, B1); PG8_BAR; PG8_SCHED;
        }
        if constexpr (ALIGN_EPI) { if (wr == 0) PG8_BAR; }
        if constexpr (FP8) asm volatile("s_nop 15\n\ts_nop 15" ::: "memory");
        { int fr_ = fr, fq_ = fq; asm volatile("" : "+v"(fr_), "+v"(fq_));
          E(acc, cur, wr, wc, fr_, fq_); }
        if (!has_next) break;
#pragma unroll
        for (int a = 0; a < 2; ++a)
#pragma unroll
            for (int b = 0; b < 2; ++b)
#pragma unroll
                for (int m = 0; m < 4; ++m)
#pragma unroll
                    for (int n = 0; n < 2; ++n) acc[a][b][m][n] = (f32x4){0.f, 0.f, 0.f, 0.f};
        cur = nxt; cA = nA; cB = nB; ++ui;
        if constexpr (Sched::GATHER) S.voff(cur, vAc);
        if constexpr (ALIGN_EPI) { if (wr == 1) PG8_BAR; }
    }
    PG8_WAIT_V(0);
    if constexpr (!ALIGN_EPI) { if (wr == 0) PG8_BAR; }
    PG8_BAR;
#undef PG8_SA
#undef PG8_SB
#undef PG8_STAGE2
#undef PG8_STAGEB
#undef PG8_LDA
#undef PG8_LDB
#undef PG8_MMA
#undef PG8_WAIT_V
#undef PG8_WAIT_L
#undef PG8_BAR
#undef PG8_SCHED
}
}

#define XB_TMO      128
#define XB_XCNT(j)  (256  + 64 * (j))
#define XB_XSUB(j)  (1280 + 64 * (j))
#define XB_XGEN(j)  (2304 + 64 * (j))
#define XB_TOP      3328
#define XB_TOPGEN   3392
#define XCD_BAR_WORDS 3456
#define XB_SPIN_CAP (1u << 18)

__device__ __forceinline__ unsigned xb_ld(unsigned* p)              { return __hip_atomic_load(p, __ATOMIC_RELAXED, __HIP_MEMORY_SCOPE_AGENT); }
__device__ __forceinline__ unsigned xb_add(unsigned* p, unsigned v) { return __hip_atomic_fetch_add(p, v, __ATOMIC_RELAXED, __HIP_MEMORY_SCOPE_AGENT); }
__device__ __forceinline__ unsigned xb_xcc_id() { return (unsigned)__builtin_amdgcn_s_getreg((3 << 11) | 20) & 0xFu; }
#define XB_SPIN(cond, bar) do { unsigned _sp = 0; while (cond) { __builtin_amdgcn_s_sleep(1); \
    if ((++_sp & 255u) == 0u) { if (xb_ld(&(bar)[XB_TMO])) break; if (_sp > XB_SPIN_CAP) { atomicAdd(&(bar)[XB_TMO], 1u); break; } } } } while (0)

struct XcdBarrier { unsigned* bar; unsigned x; volatile LAS unsigned* st; };

__device__ __forceinline__ XcdBarrier xcd_barrier_post(unsigned* bar, volatile LAS unsigned* st) {
    XcdBarrier b; b.bar = bar; b.x = xb_xcc_id(); b.st = st;
    if (threadIdx.x == 0) (void)xb_add(&bar[XB_XCNT(b.x)], 1u);
    return b;
}
__device__ __forceinline__ void xcd_barrier_complete(unsigned* bar, unsigned x, unsigned& nloc, unsigned& nx) {
    const unsigned G = gridDim.x * gridDim.y * gridDim.z;
    unsigned sum, cnt, mine, sp = 0u;
    for (;;) {
        sum = 0u; cnt = 0u; mine = 0u;
#pragma unroll
        for (unsigned j = 0; j < 16; ++j) { const unsigned c = xb_ld(&bar[XB_XCNT(j)]); sum += c; cnt += (c > 0u) ? 1u : 0u; mine = (j == x) ? c : mine; }
        if (sum == G) break;
        __builtin_amdgcn_s_sleep(1);
        if ((++sp & 255u) == 0u) { if (xb_ld(&bar[XB_TMO])) break; if (sp > XB_SPIN_CAP) { atomicAdd(&bar[XB_TMO], 1u); break; } }
    }
    nloc = mine > 0u ? mine : 1u; nx = cnt > 0u ? cnt : 1u;
}
__device__ __forceinline__ void xcd_barrier(const XcdBarrier& b) {
    asm volatile("s_waitcnt vmcnt(0)" ::: "memory");
    __syncthreads();
    if (threadIdx.x == 0) {
        unsigned* bar = b.bar;
        __builtin_amdgcn_s_waitcnt(0);
        unsigned nloc = b.st[0], nx = b.st[1];
        if (nloc == 0u) { xcd_barrier_complete(bar, b.x, nloc, nx); b.st[0] = nloc; b.st[1] = nx; }
        const unsigned old = xb_add(&bar[XB_XSUB(b.x)], 1u);
        const unsigned gen = old / nloc;
        if (old + 1u == (gen + 1u) * nloc) {
            __builtin_amdgcn_fence(__ATOMIC_RELEASE, "agent");
            asm volatile("s_waitcnt vmcnt(0)" ::: "memory");
            const unsigned og = xb_add(&bar[XB_TOP], 1u);
            const unsigned tg = og / nx;
            if (og + 1u == (tg + 1u) * nx) xb_add(&bar[XB_TOPGEN], 1u);
            else XB_SPIN(xb_ld(&bar[XB_TOPGEN]) == tg, bar);
            __builtin_amdgcn_fence(__ATOMIC_ACQUIRE, "agent");
            xb_add(&bar[XB_XGEN(b.x)], 1u);
            asm volatile("s_waitcnt vmcnt(0)" ::: "memory");
        } else {
            XB_SPIN(xb_ld(&bar[XB_XGEN(b.x)]) == gen, bar);
            __builtin_amdgcn_fence(__ATOMIC_ACQUIRE, "agent");
            asm volatile("s_waitcnt vmcnt(0)" ::: "memory");
        }
    }
    __syncthreads();
}

struct Frame {
    LAS unsigned char* lds;
    int tid, lane, wave, vcu, G;
    float* out; unsigned char* ws;
};

__device__ __forceinline__ float wave_sum(float v) {
#pragma unroll
    for (int o = 1; o < 64; o <<= 1) v += __shfl_xor(v, o);
    return v;
}

__device__ __forceinline__ void cvt_load(const float* W, int Nsrc, int k0, int n0, int wave, int lane, f32x4 (&v)[8]) {
#pragma unroll
    for (int rr = 0; rr < 8; ++rr) v[rr] = __builtin_nontemporal_load((const GAS f32x4*)(W + (size_t)(k0 + wave * 8 + rr) * Nsrc + n0 + 4 * lane));
}
template <class DMap>
__device__ __forceinline__ void cvt_store(Frame& F, const f32x4 (&v)[8], const float* gain, int k0, int n0, bf16* WT, const DMap& dmap) {
    LAS float* scr = (LAS float*)F.lds;
    const int wave = F.wave, lane = F.lane;
#pragma unroll
    for (int rr = 0; rr < 8; ++rr) { const int k = wave * 8 + rr; *(LAS f32x4*)(scr + k * 256 + ((lane ^ wave) & 63) * 4) = v[rr]; }
    __syncthreads();
    const int kg = lane & 7, nl = lane >> 3;
    f32x4 g0 = (f32x4){1.f, 1.f, 1.f, 1.f}, g1 = g0;
    if (gain) { g0 = *(const GAS f32x4*)(gain + k0 + 8 * kg); g1 = *(const GAS f32x4*)(gain + k0 + 8 * kg + 4); }
#pragma unroll
    for (int s = 0; s < 4; ++s) {
        const int n = (s * 8 + wave) * 8 + nl, quad = n >> 2, c = n & 3;
        float e[8];
#pragma unroll
        for (int kk = 0; kk < 8; ++kk) e[kk] = scr[(8 * kg + kk) * 256 + ((quad ^ kg) * 4) + c];
        u32x4 o; o.x = cvt_pk_bf16(e[0] * g0[0], e[1] * g0[1]); o.y = cvt_pk_bf16(e[2] * g0[2], e[3] * g0[3]); o.z = cvt_pk_bf16(e[4] * g1[0], e[5] * g1[1]); o.w = cvt_pk_bf16(e[6] * g1[2], e[7] * g1[3]);
        *(GAS u32x4*)(WT + (size_t)dmap(n0 + n) * 1024 + k0 + 8 * kg) = o;
    }
    __syncthreads();
}
struct MapIdent { int base; __device__ __forceinline__ int operator()(int n) const { return base + n; } };
struct MapInProj { __device__ __forceinline__ int operator()(int n) const { if (n >= 1024) return n; const int s = n >> 9, c = n & 511; return 256 * (c >> 7) + 128 * s + (c & 127); } };
__device__ __forceinline__ void cvt8_load(const float* W, int k0, int n0, int wave, int lane, f32x4 (&v)[8]) {
#pragma unroll
    for (int rr = 0; rr < 8; ++rr) v[rr] = __builtin_nontemporal_load((const GAS f32x4*)(W + (size_t)(k0 + wave * 16 + 2 * rr + (lane >> 5)) * 1024 + n0 + 4 * (lane & 31)));
}
__device__ __forceinline__ void cvt8_store(Frame& F, const f32x4 (&v)[8], const float* gain, int k0, unsigned char* WT  ) {
    LAS float* scr = (LAS float*)F.lds;
    const int wave = F.wave, lane = F.lane;
#pragma unroll
    for (int rr = 0; rr < 8; ++rr) { const int k = wave * 16 + 2 * rr + (lane >> 5); *(LAS f32x4*)(scr + k * 128 + (((lane & 31) ^ (wave & 7)) * 4)) = v[rr]; }
    __syncthreads();
    const int kg = lane & 7, nl = lane >> 3;
    f32x4 g[4];
#pragma unroll
    for (int i = 0; i < 4; ++i) g[i] = gain ? *(const GAS f32x4*)(gain + k0 + 16 * kg + 4 * i) * SW : (f32x4){SW, SW, SW, SW};
#pragma unroll
    for (int s = 0; s < 2; ++s) {
        const int n = (s * 8 + wave) * 8 + nl, quad = n >> 2, c = n & 3;
        float e[16];
#pragma unroll
        for (int kk = 0; kk < 16; ++kk) e[kk] = scr[(16 * kg + kk) * 128 + ((quad ^ kg) * 4) + c];
        u32x4 o; o.x = pk4_fp8(e[0] * g[0][0], e[1] * g[0][1], e[2] * g[0][2], e[3] * g[0][3]); o.y = pk4_fp8(e[4] * g[1][0], e[5] * g[1][1], e[6] * g[1][2], e[7] * g[1][3]);
        o.z = pk4_fp8(e[8] * g[2][0], e[9] * g[2][1], e[10] * g[2][2], e[11] * g[2][3]); o.w = pk4_fp8(e[12] * g[3][0], e[13] * g[3][1], e[14] * g[3][2], e[15] * g[3][3]);
        *(GAS u32x4*)(WT + (size_t)n * 1024 + k0 + 16 * kg) = o;
    }
    __syncthreads();
}

constexpr int N_CVT_ITEMS = 96 * 64 + 160 + 64;
struct P0Ptrs { const float *x, *g_mix, *w_in, *w_out, *g_ffn, *w_gate, *w_up, *w_down; };
__device__ __forceinline__ void cvt_item_src(const P0Ptrs& P, int it, const float*& W, int& Nsrc, int& k0, int& n0) {
    if (it < 6144) { const int mat = it >> 6, rem = it & 63, which = mat >> 5, e = mat & 31; const float* wg_ = P.w_gate; const float* wu_ = P.w_up; const float* wd_ = P.w_down; const float* base = wg_; if (which == 1) base = wu_; if (which == 2) base = wd_;
        W = base + (size_t)e * 1024 * 1024; Nsrc = 1024; k0 = (rem >> 3) * 128; n0 = (rem & 7) * 128; }
    else if (it < 6304) { const int r = it - 6144; W = P.w_in; Nsrc = DIN; k0 = (r / 10) * 64; n0 = (r % 10) * 256; }
    else { const int r = it - 6304; W = P.w_out; Nsrc = 1024; k0 = (r >> 2) * 64; n0 = (r & 3) * 256; }
}
__device__ __forceinline__ void cvt_item_store(Frame& F, const P0Ptrs& P, int it, const f32x4 (&v)[8]) {
    if (it < 6144) { const int mat = it >> 6, rem = it & 63, which = mat >> 5, e = mat & 31; const int k0 = (rem >> 3) * 128, nt = rem & 7;
        if (which == 2) cvt8_store(F, v, nullptr, k0, F.ws + WS_WD + ((size_t)e * 1024 + 128 * nt) * 1024);
        else cvt8_store(F, v, P.g_ffn, k0, F.ws + WS_WGU + ((size_t)e * 2048 + 256 * nt + 128 * which) * 1024); }
    else if (it < 6304) { const int r = it - 6144; cvt_store(F, v, P.g_mix, (r / 10) * 64, (r % 10) * 256, (bf16*)(F.ws + WS_WIN), MapInProj{}); }
    else { const int r = it - 6304; cvt_store(F, v, nullptr, (r >> 2) * 64, (r & 3) * 256, (bf16*)(F.ws + WS_WOUT), MapIdent{0}); }
}
__device__ __forceinline__ void p0_load_item(Frame& F, const P0Ptrs& P, int it, f32x4 (&v)[8]) {
    const float* W; int Nsrc, k0, n0; cvt_item_src(P, it, W, Nsrc, k0, n0);
    if (it < 6144) cvt8_load(W, k0, n0, F.wave, F.lane, v); else cvt_load(W, Nsrc, k0, n0, F.wave, F.lane, v);
}
__device__ __forceinline__ void p0_prologue(Frame& F, const P0Ptrs& P) {
    { const int gw = F.vcu * 8 + F.wave, NGW = F.G * 8; bf16* XB = (bf16*)(F.ws + WS_XB); float* rs1 = (float*)(F.ws + WS_RS1);
      for (int m0 = gw; m0 < T; m0 += 2 * NGW) {
        f32x4 v[2][4];
#pragma unroll
        for (int a = 0; a < 2; ++a) { const int m = (m0 + a * NGW) < T ? (m0 + a * NGW) : m0; const GAS f32x4* xr = (const GAS f32x4*)(P.x + (size_t)m * D) + F.lane;
#pragma unroll
            for (int j = 0; j < 4; ++j) v[a][j] = __builtin_nontemporal_load(xr + 64 * j); }
#pragma unroll
        for (int a = 0; a < 2; ++a) { const int m = m0 + a * NGW; if (m >= T) break; float s = 0.f;
#pragma unroll
            for (int j = 0; j < 4; ++j) s += (v[a][j].x * v[a][j].x + v[a][j].y * v[a][j].y) + (v[a][j].z * v[a][j].z + v[a][j].w * v[a][j].w);
            s = wave_sum(s);
            if (F.lane == 0) rs1[m] = 1.0f / sqrtf(s * (1.0f / D) + EPS);
            GAS u32x2* o8 = (GAS u32x2*)(XB + (size_t)m * D) + F.lane;
#pragma unroll
            for (int j = 0; j < 4; ++j) { u32x2 w; w.x = cvt_pk_bf16(v[a][j].x, v[a][j].y); w.y = cvt_pk_bf16(v[a][j].z, v[a][j].w); o8[64 * j] = w; } }
      } }
    const int G = F.G; int it = F.vcu; if (it >= N_CVT_ITEMS) return;
    f32x4 ta[8], tb[8], tc[8];
    p0_load_item(F, P, it, ta);
    if (it + G < N_CVT_ITEMS) p0_load_item(F, P, it + G, tb);
    for (;;) {
        if (it + 2 * G < N_CVT_ITEMS) p0_load_item(F, P, it + 2 * G, tc);
        cvt_item_store(F, P, it, ta); it += G; if (it >= N_CVT_ITEMS) break;
        if (it + 2 * G < N_CVT_ITEMS) p0_load_item(F, P, it + 2 * G, ta);
        cvt_item_store(F, P, it, tb); it += G; if (it >= N_CVT_ITEMS) break;
        if (it + 2 * G < N_CVT_ITEMS) p0_load_item(F, P, it + 2 * G, tb);
        cvt_item_store(F, P, it, tc); it += G; if (it >= N_CVT_ITEMS) break;
    }
}

typedef const f32x4 (&AccRef)[2][2][4][2];
struct EpiInProj {
    const float* rs1; const float* b_in; bf16* U; bf16* Q; bf16* Kk;
    __device__ __forceinline__ void operator()(AccRef acc, const pg8::Unit& u, int wr, int wc, int fr, int fq) const {
        const int row0 = u.pm * 256 + wr * 64 + fr, cl = wc * 32 + 8 * fq;
        if (u.pn < 4) {
            const int ch = 128 * u.pn + cl;
            f32x4 ba[2], bg[2];
#pragma unroll
            for (int n = 0; n < 2; ++n) { ba[n] = *(const GAS f32x4*)(b_in + ch + 4 * n); bg[n] = *(const GAS f32x4*)(b_in + 512 + ch + 4 * n); }
#pragma unroll
            for (int ai = 0; ai < 2; ++ai)
#pragma unroll
                for (int m = 0; m < 4; ++m) { const int row = row0 + ai * 128 + m * 16; const float rs = rs1[row];
                    float o[8];
#pragma unroll
                    for (int n = 0; n < 2; ++n)
#pragma unroll
                        for (int j = 0; j < 4; ++j) { const float a = acc[ai][0][m][n][j] * rs + ba[n][j], g = acc[ai][1][m][n][j] * rs + bg[n][j]; o[4 * n + j] = a * sigmoidf_(g); }
                    u32x4 w; w.x = cvt_pk_bf16(o[0], o[1]); w.y = cvt_pk_bf16(o[2], o[3]); w.z = cvt_pk_bf16(o[4], o[5]); w.w = cvt_pk_bf16(o[6], o[7]);
                    *(GAS u32x4*)(U + (size_t)row * 512 + ch) = w; }
        } else {
            const int t = (u.pn - 4) >> 1; bf16* O = t == 0 ? Q : Kk; const int colt = ((u.pn - 4) & 1) * 256 + cl; const float* bias = b_in + 1024 + 512 * t + colt;
            f32x4 bv[2][2];
#pragma unroll
            for (int bj = 0; bj < 2; ++bj)
#pragma unroll
                for (int n = 0; n < 2; ++n) bv[bj][n] = *(const GAS f32x4*)(bias + bj * 128 + 4 * n);
#pragma unroll
            for (int ai = 0; ai < 2; ++ai)
#pragma unroll
                for (int m = 0; m < 4; ++m) { const int row = row0 + ai * 128 + m * 16; const float rs = rs1[row];
#pragma unroll
                    for (int bj = 0; bj < 2; ++bj) { const f32x4 v0 = acc[ai][bj][m][0] * rs + bv[bj][0], v1 = acc[ai][bj][m][1] * rs + bv[bj][1];
                        u32x4 w; w.x = cvt_pk_bf16(v0[0], v0[1]); w.y = cvt_pk_bf16(v0[2], v0[3]); w.z = cvt_pk_bf16(v1[0], v1[1]); w.w = cvt_pk_bf16(v1[2], v1[3]);
                        const int cc = colt + bj * 128;
                        *(GAS u32x4*)(O + ((size_t)((row >> 6) * 8 + (cc >> 6)) * 64 + (row & 63)) * 64 + (cc & 63)) = w; } }
        }
    }
};
struct EpiVt {
    const float* rs1; const float* b_v; bf16* Vt;
    __device__ __forceinline__ void operator()(AccRef acc, const pg8::Unit& u, int wr, int wc, int fr, int fq) const {
        const int c0 = u.pm * 256 + wr * 64 + fr, t0 = u.pn * 256 + wc * 32 + 8 * fq;
        f32x4 rv[2][2];
#pragma unroll
        for (int bj = 0; bj < 2; ++bj)
#pragma unroll
            for (int n = 0; n < 2; ++n) rv[bj][n] = *(const GAS f32x4*)(rs1 + t0 + bj * 128 + 4 * n);
#pragma unroll
        for (int ai = 0; ai < 2; ++ai)
#pragma unroll
            for (int m = 0; m < 4; ++m) { const int c = c0 + ai * 128 + m * 16; const float bb = b_v[c];
#pragma unroll
                for (int bj = 0; bj < 2; ++bj) { const int t = t0 + bj * 128; const f32x4 v0 = acc[ai][bj][m][0] * rv[bj][0] + bb, v1 = acc[ai][bj][m][1] * rv[bj][1] + bb;
                    u32x4 w; w.x = cvt_pk_bf16(v0[0], v0[1]); w.y = cvt_pk_bf16(v0[2], v0[3]); w.z = cvt_pk_bf16(v1[0], v1[1]); w.w = cvt_pk_bf16(v1[2], v1[3]);
                    *(GAS u32x4*)(Vt + ((size_t)((t >> 6) * 8 + (c >> 6)) * 64 + (c & 63)) * 64 + (t & 63)) = w; } }
    }
};
struct EpiOut {
    const float* x; const float* b_out; float* h; unsigned char* h8; float* ssq;
    __device__ __forceinline__ void operator()(AccRef acc, const pg8::Unit& u, int wr, int wc, int fr, int fq) const {
        const int row0 = u.pm * 256 + wr * 64 + fr, col0 = u.pn * 256 + wc * 32 + 8 * fq;
        f32x4 bv[2][2];
#pragma unroll
        for (int bj = 0; bj < 2; ++bj)
#pragma unroll
            for (int n = 0; n < 2; ++n) bv[bj][n] = *(const GAS f32x4*)(b_out + col0 + bj * 128 + 4 * n);
#pragma unroll
        for (int ai = 0; ai < 2; ++ai)
#pragma unroll
            for (int m = 0; m < 4; ++m) { const int row = row0 + ai * 128 + m * 16; const size_t off = (size_t)row * D + col0; float s = 0.f;
#pragma unroll
                for (int bj = 0; bj < 2; ++bj) {
                    const f32x4 x0 = *(const GAS f32x4*)(x + off + bj * 128), x1 = *(const GAS f32x4*)(x + off + bj * 128 + 4);
                    const f32x4 v0 = acc[ai][bj][m][0] + bv[bj][0] + x0, v1 = acc[ai][bj][m][1] + bv[bj][1] + x1;
                    s += (v0[0] * v0[0] + v0[1] * v0[1]) + (v0[2] * v0[2] + v0[3] * v0[3]) + (v1[0] * v1[0] + v1[1] * v1[1]) + (v1[2] * v1[2] + v1[3] * v1[3]);
                    *(GAS f32x4*)(h + off + bj * 128) = v0; *(GAS f32x4*)(h + off + bj * 128 + 4) = v1;
                    u32x2 w; w.x = pk4_fp8(v0[0] * SA, v0[1] * SA, v0[2] * SA, v0[3] * SA); w.y = pk4_fp8(v1[0] * SA, v1[1] * SA, v1[2] * SA, v1[3] * SA);
                    *(GAS u32x2*)(h8 + off + bj * 128) = w; }
                s += __shfl_xor(s, 16); s += __shfl_xor(s, 32);
                if (fq == 0) ssq[(size_t)row * 16 + u.pn * 4 + wc] = s; }
    }
};
struct EpiGU {
    const pg8::GroupedOrder<true>* S; const LAS float* rowf; const LAS float* biasL; unsigned char* HD;
    __device__ __forceinline__ void operator()(AccRef acc, const pg8::Unit& u, int wr, int wc, int fr, int fq) const {
        int ue, urow0, unvalid; S->meta(u, ue, urow0, unvalid);
        const int rl0 = wr * 64 + fr, ch = 128 * u.pn + wc * 32 + 8 * fq;
        f32x4 bg[2], bu[2];
#pragma unroll
        for (int n = 0; n < 2; ++n) { bg[n] = *(const LAS f32x4*)(biasL + u.slot * 256 + wc * 32 + 8 * fq + 4 * n); bu[n] = *(const LAS f32x4*)(biasL + u.slot * 256 + 128 + wc * 32 + 8 * fq + 4 * n); }
#pragma unroll
        for (int ai = 0; ai < 2; ++ai)
#pragma unroll
            for (int m = 0; m < 4; ++m) { const int rl = rl0 + ai * 128 + m * 16; const float rs = rowf[u.slot * 256 + rl];
                float o[8];
#pragma unroll
                for (int n = 0; n < 2; ++n)
#pragma unroll
                    for (int j = 0; j < 4; ++j) { float gt = acc[ai][0][m][n][j] * rs + bg[n][j], up = acc[ai][1][m][n][j] * rs + bu[n][j];
                        gt = fminf(gt, 7.0f); up = fminf(fmaxf(up, -7.0f), 7.0f);
                        o[4 * n + j] = (up + 1.0f) * gt * fast_rcp(1.0f + fast_exp2(-1.702f * LOG2E * gt)); }
                if (rl < unvalid) { u32x2 w; w.x = pk4_fp8(o[0] * SH, o[1] * SH, o[2] * SH, o[3] * SH); w.y = pk4_fp8(o[4] * SH, o[5] * SH, o[6] * SH, o[7] * SH);
                    *(GAS u32x2*)(HD + (size_t)(urow0 + rl) * DFF + ch) = w; } }
    }
};
struct EpiDown {
    const pg8::GroupedOrder<false>* S; const LAS float* rowf; const LAS float* biasL; unsigned char* Y;
    __device__ __forceinline__ void operator()(AccRef acc, const pg8::Unit& u, int wr, int wc, int fr, int fq) const {
        int ue, urow0, unvalid; S->meta(u, ue, urow0, unvalid);
        const int rl0 = wr * 64 + fr, col0 = u.pn * 256 + wc * 32 + 8 * fq;
        f32x4 bv[2][2];
#pragma unroll
        for (int bj = 0; bj < 2; ++bj)
#pragma unroll
            for (int n = 0; n < 2; ++n) bv[bj][n] = *(const LAS f32x4*)(biasL + u.slot * 256 + wc * 32 + 8 * fq + bj * 128 + 4 * n);
#pragma unroll
        for (int ai = 0; ai < 2; ++ai)
#pragma unroll
            for (int m = 0; m < 4; ++m) { const int rl = rl0 + ai * 128 + m * 16; const float gt = rowf[u.slot * 256 + rl];
                if (rl < unvalid) {
#pragma unroll
                    for (int bj = 0; bj < 2; ++bj) { const f32x4 v0 = (acc[ai][bj][m][0] * (1.0f / (SH * SW)) + bv[bj][0]) * gt, v1 = (acc[ai][bj][m][1] * (1.0f / (SH * SW)) + bv[bj][1]) * gt;
                        u32x2 w; w.x = pk4_fp8(v0[0], v0[1], v0[2], v0[3]); w.y = pk4_fp8(v1[0], v1[1], v1[2], v1[3]);
                        *(GAS u32x2*)(Y + (size_t)(urow0 + rl) * D + col0 + bj * 128) = w; } } }
    }
};

constexpr int CV_T = 32, CV_ROWS = CV_T + 30;
constexpr int CV_IN = 0, CV_OUT = 65536;
__device__ __forceinline__ void conv_unit(Frame& F, const float* ln_g, const float* ln_b, int t0, const float (&w0)[31], const float (&w1)[31], float cb0, float cb1) {
    const bf16* U = (const bf16*)(F.ws + WS_U); bf16* MIX = (bf16*)(F.ws + WS_MIX);
    LAS unsigned char* lin = F.lds + CV_IN; LAS float* lout = (LAS float*)(F.lds + CV_OUT);
    for (int p = F.tid; p < CV_ROWS * 64; p += 512) { const int r = p >> 6, c = p & 63; const int t = t0 - 15 + r;
        u32x4 v = (u32x4){0u, 0u, 0u, 0u}; if (t >= 0 && t < T) v = *(const GAS u32x4*)(U + (size_t)t * 512 + c * 8);
        *(LAS u32x4*)(lin + r * 1024 + c * 16) = v; }
    __syncthreads();
    { const int p = F.tid & 255, q = F.tid >> 8;
      float o0[16], o1[16];
#pragma unroll
      for (int i = 0; i < 16; ++i) { o0[i] = cb0; o1[i] = cb1; }
#pragma unroll
      for (int r = 0; r < 46; ++r) { const unsigned wv = *(const LAS unsigned*)(lin + (16 * q + r) * 1024 + p * 4); const float x0 = bf_lo(wv), x1 = bf_hi(wv);
#pragma unroll
          for (int i = 0; i < 16; ++i) { const int j = r - i; if (j >= 0 && j < 31) { o0[i] += x0 * w0[j]; o1[i] += x1 * w1[j]; } } }
#pragma unroll
      for (int i = 0; i < 16; ++i) *(LAS f32x2*)(lout + (16 * q + i) * 512 + 2 * p) = (f32x2){o0[i], o1[i]};
    }
    __syncthreads();
#pragma unroll 1
    for (int tt = 0; tt < 4; ++tt) { const int tl = F.wave * 4 + tt;
        const f32x4 a = *(const LAS f32x4*)(lout + tl * 512 + 4 * F.lane), b = *(const LAS f32x4*)(lout + tl * 512 + 256 + 4 * F.lane);
        float s = (a[0] + a[1]) + (a[2] + a[3]) + (b[0] + b[1]) + (b[2] + b[3]); s = wave_sum(s); const float mu = s * (1.0f / 512.0f);
        const f32x4 da = a - mu, db = b - mu; float q2 = (da[0] * da[0] + da[1] * da[1]) + (da[2] * da[2] + da[3] * da[3]) + (db[0] * db[0] + db[1] * db[1]) + (db[2] * db[2] + db[3] * db[3]);
        q2 = wave_sum(q2); const float rstd = 1.0f / sqrtf(q2 * (1.0f / 512.0f) + EPS);
        const f32x4 ga = *(const GAS f32x4*)(ln_g + 4 * F.lane), gb = *(const GAS f32x4*)(ln_g + 256 + 4 * F.lane), ba = *(const GAS f32x4*)(ln_b + 4 * F.lane), bb = *(const GAS f32x4*)(ln_b + 256 + 4 * F.lane);
        f32x4 ya = da * rstd * ga + ba, yb = db * rstd * gb + bb;
#pragma unroll
        for (int j = 0; j < 4; ++j) { ya[j] = ya[j] * sigmoidf_(ya[j]); yb[j] = yb[j] * sigmoidf_(yb[j]); }
        u32x2 wa, wb; wa.x = cvt_pk_bf16(ya[0], ya[1]); wa.y = cvt_pk_bf16(ya[2], ya[3]); wb.x = cvt_pk_bf16(yb[0], yb[1]); wb.y = cvt_pk_bf16(yb[2], yb[3]);
        bf16* orow = MIX + (size_t)(t0 + tl) * D;
        *(GAS u32x2*)(orow + 4 * F.lane) = wa; *(GAS u32x2*)(orow + 256 + 4 * F.lane) = wb; }
    __syncthreads();
}

__device__ __forceinline__ void attn_item(Frame& F, int i, int n, int h, const LAS float* rpbL) {
    const bf16* Q = (const bf16*)(F.ws + WS_Q); const bf16* Kp = (const bf16*)(F.ws + WS_K); const bf16* Vt = (const bf16*)(F.ws + WS_VT); bf16* MIX = (bf16*)(F.ws + WS_MIX);
    const int lane = F.lane, q = lane & 15, G = lane >> 4;
    const int qc = 16 * n + q, tokq = i * 64 + qc;
    const int r0 = min(max(i - 4, 0), NROWS - 8), bs = min(max(16 * n - 8, 0), 32);
    const bf16* qp = Q + ((size_t)(i * 8 + h) * 64 + qc) * 64 + 8 * G;
    const bf16x8 Qf0 = *(const GAS bf16x8*)qp, Qf1 = *(const GAS bf16x8*)(qp + 32);
    const int kcl = 8 * (q >> 2) + (q & 3);
    bf16x8 Kf[8][2][2];
#pragma unroll
    for (int s = 0; s < 8; ++s)
#pragma unroll
        for (int odd = 0; odd < 2; ++odd) {
            const bf16* kp = Kp + ((size_t)((r0 + s) * 8 + h) * 64 + bs + kcl + 4 * odd) * 64 + 8 * G;
            Kf[s][odd][0] = *(const GAS bf16x8*)kp; Kf[s][odd][1] = *(const GAS bf16x8*)(kp + 32); }
    __builtin_amdgcn_sched_barrier(0);
    f32x4 S[8][2];
#pragma unroll
    for (int s = 0; s < 8; ++s)
#pragma unroll
        for (int odd = 0; odd < 2; ++odd) {
            f32x4 a = (f32x4){0.f, 0.f, 0.f, 0.f};
            a = __builtin_amdgcn_mfma_f32_16x16x32_bf16(Kf[s][odd][0], Qf0, a, 0, 0, 0); a = __builtin_amdgcn_mfma_f32_16x16x32_bf16(Kf[s][odd][1], Qf1, a, 0, 0, 0);
            S[s][odd] = a; }
    bf16x8 Vf[4][4];
#pragma unroll
    for (int s = 0; s < 4; ++s) { const bf16* vb = Vt + ((size_t)((r0 + s) * 8 + h) * 64 + q) * 64 + bs + 8 * G;
#pragma unroll
        for (int d = 0; d < 4; ++d) Vf[s][d] = *(const GAS bf16x8*)(vb + d * 16 * 64); }
    __builtin_amdgcn_sched_barrier(0);
    const int c0 = min(max(qc - 8, 0), GRIDW - 16);
    const LAS float* rb = rpbL + h * 465 + (bs + 8 * G - qc + 15);
    bool vld[8];
#pragma unroll
    for (int j = 0; j < 8; ++j) { const int kc = bs + 8 * G + j; vld[j] = (kc >= c0) && (kc < c0 + 16); }
    float mx = -1e30f;
#pragma unroll
    for (int s = 0; s < 8; ++s) { const LAS float* rbs = rb + (r0 + s - i + 7) * 31;
#pragma unroll
        for (int odd = 0; odd < 2; ++odd)
#pragma unroll
            for (int r = 0; r < 4; ++r) { float t = S[s][odd][r] * (0.125f * LOG2E) + rbs[4 * odd + r]; t = vld[4 * odd + r] ? t : -1e30f; S[s][odd][r] = t; mx = fmaxf(mx, t); } }
    mx = fmaxf(mx, __shfl_xor(mx, 16)); mx = fmaxf(mx, __shfl_xor(mx, 32));
    float l = 0.f; bf16x8 Pf[8];
#pragma unroll
    for (int s = 0; s < 8; ++s) { float p[8];
#pragma unroll
        for (int odd = 0; odd < 2; ++odd)
#pragma unroll
            for (int r = 0; r < 4; ++r) { const float e = fast_exp2(S[s][odd][r] - mx); p[4 * odd + r] = e; l += e; }
        u32x4 w; w.x = cvt_pk_bf16(p[0], p[1]); w.y = cvt_pk_bf16(p[2], p[3]); w.z = cvt_pk_bf16(p[4], p[5]); w.w = cvt_pk_bf16(p[6], p[7]);
        Pf[s] = __builtin_bit_cast(bf16x8, w); }
    l += __shfl_xor(l, 16); l += __shfl_xor(l, 32);
    const float inv = 1.0f / l;
    f32x4 O[4];
#pragma unroll
    for (int d = 0; d < 4; ++d) O[d] = (f32x4){0.f, 0.f, 0.f, 0.f};
    bf16x8 Vg[4][4];
#pragma unroll
    for (int s = 0; s < 4; ++s) { const bf16* vb = Vt + ((size_t)((r0 + 4 + s) * 8 + h) * 64 + q) * 64 + bs + 8 * G;
#pragma unroll
        for (int d = 0; d < 4; ++d) Vg[s][d] = *(const GAS bf16x8*)(vb + d * 16 * 64); }
    __builtin_amdgcn_sched_barrier(0);
#pragma unroll
    for (int s = 0; s < 4; ++s)
#pragma unroll
        for (int d = 0; d < 4; ++d) O[d] = __builtin_amdgcn_mfma_f32_16x16x32_bf16(Vf[s][d], Pf[s], O[d], 0, 0, 0);
#pragma unroll
    for (int s = 0; s < 4; ++s)
#pragma unroll
        for (int d = 0; d < 4; ++d) O[d] = __builtin_amdgcn_mfma_f32_16x16x32_bf16(Vg[s][d], Pf[4 + s], O[d], 0, 0, 0);
    bf16* orow = MIX + (size_t)tokq * D + 512 + h * 64 + 4 * G;
#pragma unroll
    for (int d = 0; d < 4; ++d) { u32x2 w; w.x = cvt_pk_bf16(O[d][0] * inv, O[d][1] * inv); w.y = cvt_pk_bf16(O[d][2] * inv, O[d][3] * inv); *(GAS u32x2*)(orow + 16 * d) = w; }
}

#ifndef P2_REPC
#define P2_REPC 1
#endif
#ifndef P2_REPA
#define P2_REPA 1
#endif
__device__ __forceinline__ void p2_mixer(Frame& F, const float* conv_w, const float* conv_b, const float* ln_g, const float* ln_b, const float* rpb) {
    for (int rep = 0; rep < P2_REPC; ++rep)
    { const int p = F.tid & 255; float w0[31], w1[31];
#pragma unroll
      for (int j = 0; j < 31; ++j) { const f32x2 wv = *(const GAS f32x2*)(conv_w + j * 512 + 2 * p); w0[j] = wv.x; w1[j] = wv.y; }
      const f32x2 cb = *(const GAS f32x2*)(conv_b + 2 * p);
      for (int row = F.vcu; row < NROWS; row += F.G) { conv_unit(F, ln_g, ln_b, row * 64, w0, w1, cb.x, cb.y); conv_unit(F, ln_g, ln_b, row * 64 + 32, w0, w1, cb.x, cb.y); } }
    LAS float* rpbL = (LAS float*)F.lds + 64;
    for (int p = F.tid; p < NHEAD * 465; p += 512) rpbL[p] = rpb[p] * LOG2E;
    __syncthreads();
    for (int rep = 0; rep < P2_REPA; ++rep)
    for (int row = F.vcu; row < NROWS; row += F.G)
#pragma unroll 1
        for (int n = 0; n < 4; ++n) attn_item(F, row, n, F.wave, rpbL);
    __syncthreads();
}

constexpr int RT_W = 0;
constexpr int RT_LOGIT = 73728;
constexpr int RT_HIST = RT_LOGIT + 8192;
__device__ __forceinline__ void p4_router(Frame& F, const float* w_router, const float* g_ffn, const float* b_router) {
    const float* h = F.out; const float* ssq = (const float*)(F.ws + WS_SSQ); float* rs2 = (float*)(F.ws + WS_RS2);
    unsigned* erank = (unsigned*)(F.ws + WS_ERANK); int* list = (int*)(F.ws + WS_LIST); float* glist = (float*)(F.ws + WS_GLIST);
    unsigned* gcount = (unsigned*)(F.ws + WS_CTL) + CW_GCOUNT;
    LAS float* wl = (LAS float*)(F.lds + RT_W); LAS float* logitL = (LAS float*)(F.lds + RT_LOGIT); LAS unsigned* hist = (LAS unsigned*)(F.lds + RT_HIST);
    const int lane = F.lane, th = lane >> 5, ks = lane & 31, g4 = lane >> 4, k16 = lane & 15;
    for (int blk = F.vcu; blk < T / 64; blk += F.G) {
        const int tb = blk * 64 + F.wave * 8 + th * 4;
        const int tg = blk * 64 + F.wave * 8 + g4 * 2;
        float acc[2][32];
#pragma unroll
        for (int a = 0; a < 2; ++a)
#pragma unroll
            for (int e = 0; e < 32; ++e) acc[a][e] = 0.f;
#pragma unroll 1
        for (int hf = 0; hf < 2; ++hf) {
            { f32x4 wv[8]; float gv[8];
#pragma unroll
              for (int i = 0; i < 8; ++i) { const int q = F.tid + 512 * i, kk = q >> 3; wv[i] = *(const GAS f32x4*)(w_router + (size_t)(hf * 512 + kk) * 32 + 4 * (q & 7)); gv[i] = g_ffn[hf * 512 + kk]; }
              __syncthreads();
#pragma unroll
              for (int i = 0; i < 8; ++i) { const int q = F.tid + 512 * i, kk = q >> 3; *(LAS f32x4*)(wl + kk * 36 + 4 * (q & 7)) = wv[i] * gv[i]; } }
            if (F.tid < 64) hist[F.tid] = 0u;
            __syncthreads();
            const float* hp0 = h + (size_t)tg * D + hf * 512 + 4 * k16; const float* hp1 = hp0 + D;
            f32x4 h0 = *(const GAS f32x4*)hp0, h1 = *(const GAS f32x4*)hp1;
#pragma unroll 1
            for (int cc = 0; cc < 8; ++cc) { const int kb = 4 * (k16 + 16 * cc); const int cn = cc < 7 ? cc + 1 : cc;
                const f32x4 n0 = *(const GAS f32x4*)(hp0 + 64 * cn), n1 = *(const GAS f32x4*)(hp1 + 64 * cn);
#pragma unroll
                for (int c = 0; c < 4; ++c) {
#pragma unroll
                    for (int e4 = 0; e4 < 8; ++e4) { const f32x4 w = *(const LAS f32x4*)(wl + (kb + c) * 36 + 4 * e4);
#pragma unroll
                        for (int j = 0; j < 4; ++j) { acc[0][4 * e4 + j] += h0[c] * w[j]; acc[1][4 * e4 + j] += h1[c] * w[j]; } } }
                h0 = n0; h1 = n1; }
        }
        float r32[32], r16[16], r8[8], r4[4];
#pragma unroll
        for (int i = 0; i < 32; ++i) { const bool up = (lane & 8) != 0; const float send = up ? acc[0][i] : acc[1][i], keep = up ? acc[1][i] : acc[0][i]; r32[i] = keep + __shfl_xor(send, 8); }
#pragma unroll
        for (int i = 0; i < 16; ++i) { const bool up = (lane & 4) != 0; const float send = up ? r32[i] : r32[i + 16], keep = up ? r32[i + 16] : r32[i]; r16[i] = keep + __shfl_xor(send, 4); }
#pragma unroll
        for (int i = 0; i < 8; ++i) { const bool up = (lane & 2) != 0; const float send = up ? r16[i] : r16[i + 8], keep = up ? r16[i + 8] : r16[i]; r8[i] = keep + __shfl_xor(send, 2); }
#pragma unroll
        for (int i = 0; i < 4; ++i) { const bool up = (lane & 1) != 0; const float send = up ? r8[i] : r8[i + 4], keep = up ? r8[i + 4] : r8[i]; r4[i] = keep + __shfl_xor(send, 1); }
        *(LAS f32x4*)(logitL + (F.wave * 8 + g4 * 2 + (k16 >> 3)) * 32 + 4 * (k16 & 7)) = (f32x4){r4[0], r4[1], r4[2], r4[3]};
        LDS_WAIT(); asm volatile("" ::: "memory");
        int myE[4]; float myG[4]; unsigned myR[4];
#pragma unroll
        for (int a = 0; a < 4; ++a) { const int tok = tb + a;
            float sp = ks < 16 ? ssq[(size_t)tok * 16 + ks] : 0.f;
#pragma unroll
            for (int o = 1; o < 16; o <<= 1) sp += __shfl_xor(sp, o);
            sp = __shfl(sp, lane & 32);
            const float rs = 1.0f / sqrtf(sp * (1.0f / D) + EPS);
            if (ks == 0) rs2[tok] = rs;
            const float v = logitL[(F.wave * 8 + th * 4 + a) * 32 + ks] * rs + b_router[ks];
            bool taken = false; float tv[4]; int ti[4];
#pragma unroll
            for (int r = 0; r < 4; ++r) { float bv = taken ? -3.0e38f : v; int bi = ks;
#pragma unroll
                for (int o = 1; o < 32; o <<= 1) { const float ov = __shfl_xor(bv, o); const int oi = __shfl_xor(bi, o); if (ov > bv || (ov == bv && oi < bi)) { bv = ov; bi = oi; } }
                tv[r] = bv; ti[r] = bi; if (bi == ks) taken = true; }
            const float e1 = __expf(tv[1] - tv[0]), e2 = __expf(tv[2] - tv[0]), e3 = __expf(tv[3] - tv[0]); const float inv = 1.0f / (1.0f + e1 + e2 + e3);
            const float gsel = ks == 0 ? inv : (ks == 1 ? e1 * inv : (ks == 2 ? e2 * inv : e3 * inv)); const int esel = ks == 0 ? ti[0] : (ks == 1 ? ti[1] : (ks == 2 ? ti[2] : ti[3]));
            myE[a] = esel; myG[a] = gsel; myR[a] = 0u;
            if (ks < 4) myR[a] = __hip_atomic_fetch_add(hist + esel, 1u, __ATOMIC_RELAXED, __HIP_MEMORY_SCOPE_WORKGROUP); }
        __syncthreads();
        if (F.tid < 32) hist[32 + F.tid] = __hip_atomic_fetch_add(gcount + F.tid, hist[F.tid], RLX_AGENT);
        __syncthreads();
        if (ks < 4) {
#pragma unroll
            for (int a = 0; a < 4; ++a) { const unsigned rank = hist[32 + myE[a]] + myR[a]; const int tok = tb + a;
                list[myE[a] * 16384 + rank] = tok; glist[myE[a] * 16384 + rank] = myG[a]; erank[tok * 4 + ks] = ((unsigned)myE[a] << 16) | rank; } }
    }
    __syncthreads();
}

__device__ __forceinline__ int grouped_setup(Frame& F, int ntn, bool gate_mode, const float* bias0, const float* bias1) {
    LAS int* tile = (LAS int*)(F.lds + AT_TILE); LAS int* offs = (LAS int*)(F.lds + AT_OFFS);
    LAS unsigned* tokoff = (LAS unsigned*)(F.lds + AT_TOK); LAS float* rowf = (LAS float*)(F.lds + AT_ROWF); LAS float* biasL = (LAS float*)(F.lds + AT_BIAS);
    const unsigned* gcount = (const unsigned*)(F.ws + WS_CTL) + CW_GCOUNT;
    const int* list = (const int*)(F.ws + WS_LIST); const float* glist = (const float*)(F.ws + WS_GLIST); const float* rs2 = (const float*)(F.ws + WS_RS2);
    __syncthreads();
    if (F.tid == 0) { int o = 0, nt = 0;
        for (int e = 0; e < NE; ++e) { const int c = (int)gcount[e]; offs[e] = o; offs[33 + e] = c; o += c; const int k = (c + 255) >> 8; for (int j = 0; j < k; ++j) tile[nt++] = (e << 16) | j; }
        offs[32] = o; offs[70] = nt; }
    __syncthreads();
    const int ntiles = offs[70];
    for (int i = 0; i < MAXU; ++i) { const int L = i * F.G + (int)blockIdx.x; if (L >= ntiles * ntn) break;
        const int mt = L / ntn, pn = L - mt * ntn, te = tile[mt], e = te >> 16, j = te & 0xffff, cnt = offs[33 + e];
        if (F.tid >= 256) { const int c = F.tid - 256;
            biasL[i * 256 + c] = gate_mode ? bias0[e * D + pn * 256 + c] : (c < 128 ? bias0[e * DFF + pn * 128 + c] : bias1[e * DFF + pn * 128 + c - 128]); }
        for (int r = F.tid; r < 256; r += 512) { const int pos = 256 * j + r; const bool ok = pos < cnt;
            if (gate_mode) rowf[i * 256 + r] = ok ? glist[e * 16384 + pos] * SY : 0.f;
            else { const int tok = ok ? list[e * 16384 + pos] : 0; tokoff[i * 256 + r] = (unsigned)tok * (unsigned)D; rowf[i * 256 + r] = rs2[tok] * (1.0f / (SA * SW)); } } }
    __syncthreads();
    return ntiles;
}

__device__ __forceinline__ void p7_combine(Frame& F, const float* g_final) {
    const unsigned* gcount = (const unsigned*)(F.ws + WS_CTL) + CW_GCOUNT; const unsigned* erank = (const unsigned*)(F.ws + WS_ERANK);
    LAS int* offs = (LAS int*)(F.lds + AT_OFFS);
    __syncthreads();
    if (F.tid == 0) { int o = 0; for (int e = 0; e < NE; ++e) { offs[e] = o; o += (int)gcount[e]; } }
    __syncthreads();
    const int gw = F.vcu * 8 + F.wave, NGW = F.G * 8;
    f32x4 gf[4];
#pragma unroll
    for (int j = 0; j < 4; ++j) gf[j] = *(const GAS f32x4*)(g_final + 16 * F.lane + 4 * j);
    const unsigned char* Y8 = F.ws + WS_Y;
    for (int t0 = gw; t0 < T; t0 += 2 * NGW) {
        const int tt[2] = {t0, t0 + NGW};
        f32x4 v[2][4]; u32x4 y[2][4];
#pragma unroll
        for (int a = 0; a < 2; ++a) { const int t = tt[a] < T ? tt[a] : t0;
            const u32x4 er = *(const GAS u32x4*)(erank + t * 4);
            size_t pos[4];
            pos[0] = (size_t)(offs[er.x >> 16] + (int)(er.x & 0xffffu)); pos[1] = (size_t)(offs[er.y >> 16] + (int)(er.y & 0xffffu));
            pos[2] = (size_t)(offs[er.z >> 16] + (int)(er.z & 0xffffu)); pos[3] = (size_t)(offs[er.w >> 16] + (int)(er.w & 0xffffu));
            const float* hrow = F.out + (size_t)t * D;
#pragma unroll
            for (int j = 0; j < 4; ++j) v[a][j] = *(const GAS f32x4*)(hrow + 16 * F.lane + 4 * j);
#pragma unroll
            for (int r = 0; r < 4; ++r) y[a][r] = *(const GAS u32x4*)(Y8 + pos[r] * D + 16 * F.lane); }
#pragma unroll
        for (int a = 0; a < 2; ++a) { if (tt[a] >= T) break;
            float s = 0.f;
#pragma unroll
            for (int r = 0; r < 4; ++r)
#pragma unroll
                for (int j = 0; j < 4; ++j) { const unsigned w = y[a][r][j];
                    const f32x2 lo = __builtin_amdgcn_cvt_pk_f32_fp8(w, false), hi = __builtin_amdgcn_cvt_pk_f32_fp8(w, true);
                    v[a][j][0] += lo[0] * (1.0f / SY); v[a][j][1] += lo[1] * (1.0f / SY); v[a][j][2] += hi[0] * (1.0f / SY); v[a][j][3] += hi[1] * (1.0f / SY); }
#pragma unroll
            for (int j = 0; j < 4; ++j) s += (v[a][j][0] * v[a][j][0] + v[a][j][1] * v[a][j][1]) + (v[a][j][2] * v[a][j][2] + v[a][j][3] * v[a][j][3]);
            s = wave_sum(s); const float rs = 1.0f / sqrtf(s * (1.0f / D) + EPS);
            float* orow = F.out + (size_t)tt[a] * D;
#pragma unroll
            for (int j = 0; j < 4; ++j) *(GAS f32x4*)(orow + 16 * F.lane + 4 * j) = v[a][j] * rs * gf[j]; }
    }
}

constexpr int NPHASE = 8;
struct Args { const float* in[21]; float* out; unsigned char* ws; int ph_lo, ph_hi; };
__global__ void __launch_bounds__(512, 2) enc_fwd(Args args) {
    extern __shared__ __attribute__((aligned(16))) unsigned char lds[];
    Frame F;
    F.lds = (LAS unsigned char*)lds;
    F.tid = threadIdx.x; F.lane = F.tid & 63; F.wave = __builtin_amdgcn_readfirstlane(F.tid >> 6);
    F.G = gridDim.x; { const int bx = blockIdx.x; F.vcu = (F.G % 8 == 0) ? (bx % 8) * (F.G / 8) + bx / 8 : bx; }
    F.out = args.out; F.ws = args.ws;
    volatile LAS unsigned* MISC = (volatile LAS unsigned*)(F.lds + MISC_OFF);
    if (F.tid < 64) MISC[F.tid] = 0u;
    __syncthreads();
    const int lo = args.ph_lo, hi = args.ph_hi;
    const bool use_bar = (hi - lo) > 1;
    XcdBarrier bar; bar.bar = (unsigned*)(F.ws + WS_CTL) + CW_BAR; bar.x = 0; bar.st = nullptr;
    if (use_bar) bar = xcd_barrier_post((unsigned*)(F.ws + WS_CTL) + CW_BAR, MISC + 8);
#ifndef PH_MASK
#define PH_MASK 0xff
#endif
#define IN(k) (((PH_MASK >> (k)) & 1) && lo <= (k) && (k) < hi)
#define SEAM(k) do { if (IN(k) && IN((k) + 1)) xcd_barrier(bar); } while (0)

    if (IN(0)) { P0Ptrs P{args.in[0], args.in[1], args.in[2], args.in[9], args.in[11], args.in[14], args.in[16], args.in[18]}; p0_prologue(F, P); SEAM(0); }

    if (IN(1)) {
        { pg8::StaticOrder S; S.init(F.ws + WS_XB, F.ws + WS_WIN, T, 2048, D * 2, F.G, (int)blockIdx.x);
          EpiInProj E{(const float*)(F.ws + WS_RS1), args.in[3], (bf16*)(F.ws + WS_U), (bf16*)(F.ws + WS_Q), (bf16*)(F.ws + WS_K)};
          pg8::gemm_phase<EpiInProj, pg8::StaticOrder>(F.lds, D * 2, S, E); }
        { pg8::StaticOrder S; S.init(F.ws + WS_WIN + (size_t)2048 * D * 2, F.ws + WS_XB, 512, T, D * 2, F.G, (int)blockIdx.x);
          EpiVt E{(const float*)(F.ws + WS_RS1), args.in[3] + 2048, (bf16*)(F.ws + WS_VT)};
          pg8::gemm_phase<EpiVt, pg8::StaticOrder>(F.lds, D * 2, S, E); }
        SEAM(1);
    }

    if (IN(2)) { p2_mixer(F, args.in[4], args.in[5], args.in[6], args.in[7], args.in[8]); SEAM(2); }

    if (IN(3)) {
        pg8::StaticOrder S; S.init(F.ws + WS_MIX, F.ws + WS_WOUT, T, D, D * 2, F.G, (int)blockIdx.x);
        EpiOut E{args.in[0], args.in[10], F.out, F.ws + WS_H8, (float*)(F.ws + WS_SSQ)};
        pg8::gemm_phase<EpiOut, pg8::StaticOrder>(F.lds, D * 2, S, E);
        SEAM(3);
    }

    if (IN(4)) { p4_router(F, args.in[12], args.in[11], args.in[13]); SEAM(4); }

    if (IN(5)) {
        const int ntiles = grouped_setup(F, 8, false, args.in[15], args.in[17]);
        pg8::GroupedOrder<true> S; S.A = (const char*)(F.ws + WS_H8); S.Bt = (const char*)(F.ws + WS_WGU); S.KB = D; S.ntn = 8; S.Nexp = 2048; S.G = F.G; S.c = (int)blockIdx.x; S.ntiles = ntiles;
        S.tile = (const LAS int*)(F.lds + AT_TILE); S.offs = (const LAS int*)(F.lds + AT_OFFS); S.tokoff = (const LAS unsigned*)(F.lds + AT_TOK);
        EpiGU E{&S, (const LAS float*)(F.lds + AT_ROWF), (const LAS float*)(F.lds + AT_BIAS), F.ws + WS_HD};
        pg8::gemm_phase<EpiGU, pg8::GroupedOrder<true>, true>(F.lds, D, S, E);
        SEAM(5);
    }

    if (IN(6)) {
        const int ntiles = grouped_setup(F, 4, true, args.in[19], nullptr);
        pg8::GroupedOrder<false> S; S.A = (const char*)(F.ws + WS_HD); S.Bt = (const char*)(F.ws + WS_WD); S.KB = DFF; S.ntn = 4; S.Nexp = 1024; S.G = F.G; S.c = (int)blockIdx.x; S.ntiles = ntiles;
        S.tile = (const LAS int*)(F.lds + AT_TILE); S.offs = (const LAS int*)(F.lds + AT_OFFS); S.tokoff = (const LAS unsigned*)(F.lds + AT_TOK);
        EpiDown E{&S, (const LAS float*)(F.lds + AT_ROWF), (const LAS float*)(F.lds + AT_BIAS), F.ws + WS_Y};
        pg8::gemm_phase<EpiDown, pg8::GroupedOrder<false>, true>(F.lds, DFF, S, E);
        SEAM(6);
    }

    if (IN(7)) { p7_combine(F, args.in[20]); }
#undef IN
#undef SEAM
}

extern "C" void kernel_launch(void* const* d_in, const int* in_sizes, int n_in, void* d_out, int out_size, void* d_ws, size_t ws_size, hipStream_t stream) {
    static int grid = 0;
    if (grid == 0) {
        if (n_in != 21 || out_size != T * D || ws_size < WS_END) { fprintf(stderr, "kernel_launch: unexpected problem (n_in %d, out %d, ws %zu)\n", n_in, out_size, ws_size); grid = -1; return; }
        int dev = 0, cus = 0, per_cu = 0;
        if (hipGetDevice(&dev) != hipSuccess || hipDeviceGetAttribute(&cus, hipDeviceAttributeMultiprocessorCount, dev) != hipSuccess) { grid = -1; return; }
        if (hipFuncSetAttribute((const void*)enc_fwd, hipFuncAttributeMaxDynamicSharedMemorySize, LDS_BYTES) != hipSuccess) { fprintf(stderr, "kernel_launch: cannot set %d bytes of dynamic LDS\n", LDS_BYTES); grid = -1; return; }
        if (hipOccupancyMaxActiveBlocksPerMultiprocessor(&per_cu, (const void*)enc_fwd, 512, LDS_BYTES) != hipSuccess || per_cu < 1) { fprintf(stderr, "kernel_launch: occupancy query says %d\n", per_cu); (void)hipGetLastError(); per_cu = 1; }
        grid = cus;
        if (grid != 256) { fprintf(stderr, "kernel_launch: built for a 256-CU device, got %d CUs\n", cus); grid = -1; return; }
    }
    if (grid < 0) return;
    (void)hipMemsetAsync((char*)d_ws + WS_CTL, 0, CTL_ZERO_BYTES, stream);
    Args a{};
    for (int i = 0; i < 21; ++i) a.in[i] = (const float*)d_in[i];
    a.out = (float*)d_out; a.ws = (unsigned char*)d_ws;
    if (MK_N_LAUNCHES == 1) { a.ph_lo = 0; a.ph_hi = NPHASE; hipLaunchKernelGGL(enc_fwd, dim3(grid), dim3(512), LDS_BYTES, stream, a); }
    else { for (int p = 0; p < NPHASE; ++p) { a.ph_lo = p; a.ph_hi = p + 1; hipLaunchKernelGGL(enc_fwd, dim3(grid), dim3(512), LDS_BYTES, stream, a); } }
}
```
